# Optimizing an MI355X kernel written in HIP

```python
import jax, jax.numpy as jnp
from jax import lax
import numpy as np

D_MODEL = 1024
BATCH = 2
SEQ = 16384
DEPTH = 2
DEC_BATCH = 4
DEC_SEQ = 8192
PAST_LEN = 128

RET_HEADS = 4
RET_HEAD_DIM = 128
RET_WIDTH = RET_HEADS * RET_HEAD_DIM
CHUNK = 128
FFT_GROUPS = 4
FFT_GROUP_DIM = 128
FFT_WIDTH = FFT_GROUPS * FFT_GROUP_DIM
D_FF = 2816
RMS_EPS = 1e-6
GN_EPS = 1e-6
ROPE_BASE = 10000.0
SPLITS = [RET_WIDTH, 2 * RET_WIDTH, 3 * RET_WIDTH, 4 * RET_WIDTH,
          4 * RET_WIDTH + FFT_WIDTH, 4 * RET_WIDTH + FFT_WIDTH + D_MODEL]
IN_WIDTH = 4 * RET_WIDTH + FFT_WIDTH + 2 * D_MODEL

kernel_name = "hybrid_retention_fnet_macaron_encoder"


def _rmsnorm(x, g):
    xf = x.astype(jnp.float32)
    y = xf * lax.rsqrt(jnp.mean(xf * xf, axis=-1, keepdims=True) + RMS_EPS)
    return (y * g.astype(jnp.float32)).astype(x.dtype)


def _swiglu(h, w_in, w_out):
    a, b = jnp.split(h @ w_in, 2, axis=-1)
    return (jax.nn.silu(a) * b) @ w_out


def _rotary(x, pos):
    half = x.shape[-1] // 2
    inv_freq = 1.0 / (ROPE_BASE ** jnp.linspace(0.0, 1.0, half, dtype=jnp.float32))
    ang = pos[:, None] * inv_freq[None, :]
    cos = jnp.cos(ang)[None, :, None, :]
    sin = jnp.sin(ang)[None, :, None, :]
    xf = x.astype(jnp.float32)
    x1, x2 = xf[..., 0::2], xf[..., 1::2]
    return jnp.stack([x1 * cos - x2 * sin, x1 * sin + x2 * cos], axis=-1).reshape(x.shape)


def _to_chunks(x):
    b, s, h, d = x.shape
    return x.reshape(b, s // CHUNK, CHUNK, h, d).transpose(0, 3, 1, 2, 4)


def _from_chunks(x):
    b, h, n, c, d = x.shape
    return x.transpose(0, 2, 3, 1, 4).reshape(b, n * c, h, d)


def _retention_one_dir(q, k, v, log_decay, include_diag):
    qc, kc, vc = _to_chunks(q), _to_chunks(k), _to_chunks(v)
    ld = log_decay.astype(jnp.float32)
    idx = jnp.arange(CHUNK)
    diff = (idx[:, None] - idx[None, :]).astype(jnp.float32)
    mask = (idx[:, None] >= idx[None, :]) if include_diag else (idx[:, None] > idx[None, :])
    dmat = jnp.where(mask, jnp.exp(ld[:, None, None] * jnp.where(mask, diff, 0.0)), 0.0)
    scores = jnp.einsum('bhnid,bhnjd->bhnij', qc, kc) * dmat[None, :, None]
    intra = jnp.einsum('bhnij,bhnje->bhnie', scores, vc)
    k_decay = jnp.exp(ld[:, None] * (CHUNK - 1 - idx).astype(jnp.float32))
    kv = jnp.einsum('bhnjd,bhnje->bhnde', kc * k_decay[None, :, None, :, None], vc)
    chunk_decay = jnp.exp(ld * CHUNK)[None, :, None, None]

    def step(state, kv_n):
        return chunk_decay * state + kv_n, state

    b, h = kv.shape[0], kv.shape[1]
    init = jnp.zeros((b, h, kv.shape[3], kv.shape[4]), kv.dtype)
    _, s_prev = lax.scan(step, init, jnp.moveaxis(kv, 2, 0))
    s_prev = jnp.moveaxis(s_prev, 0, 2)
    q_decay = jnp.exp(ld[:, None] * (idx + 1).astype(jnp.float32))
    inter = jnp.einsum('bhnid,bhnde->bhnie', qc * q_decay[None, :, None, :, None], s_prev)
    return _from_chunks(intra + inter)


def _bidir_retention(q, k, v, ld_fwd, ld_bwd):
    flip = lambda t: t[:, ::-1]
    fwd = _retention_one_dir(q, k, v, ld_fwd, True)
    bwd = flip(_retention_one_dir(flip(q), flip(k), flip(v), ld_bwd, False))
    return fwd + bwd


def _mixer(h, w_in, ld_fwd, ld_bwd, w_ret_out, w_fft_out, w_mix_out):
    b, s, _ = h.shape
    proj = h @ w_in
    q, k, v, g, f, gate_ret, gate_fft = jnp.split(proj, SPLITS, axis=-1)
    pos = jnp.arange(s, dtype=jnp.float32)
    q = _rotary(q.reshape(b, s, RET_HEADS, RET_HEAD_DIM), pos)
    k = _rotary(k.reshape(b, s, RET_HEADS, RET_HEAD_DIM), pos) * (RET_HEAD_DIM ** -0.5)
    v = v.reshape(b, s, RET_HEADS, RET_HEAD_DIM).astype(jnp.float32)
    y = _bidir_retention(q, k, v, ld_fwd, ld_bwd)
    mu = jnp.mean(y, axis=-1, keepdims=True)
    yc = y - mu
    yn = yc * lax.rsqrt(jnp.mean(yc * yc, axis=-1, keepdims=True) + GN_EPS)
    ret = (jax.nn.silu(g.astype(jnp.float32)) * yn.reshape(b, s, RET_WIDTH)).astype(h.dtype) @ w_ret_out
    fr = jnp.fft.fftn(f.reshape(b, s, FFT_GROUPS, FFT_GROUP_DIM).astype(jnp.float32),
                      axes=(1, 3), norm="ortho").real
    fou = fr.reshape(b, s, FFT_WIDTH).astype(h.dtype) @ w_fft_out
    merged = jax.nn.sigmoid(gate_ret) * ret + jax.nn.sigmoid(gate_fft) * fou
    return merged @ w_mix_out


def _trunk(x, g_ffn1, w_ffn1_in, w_ffn1_out, g_mix, w_in, ret_log_decay_fwd, ret_log_decay_bwd,
           w_ret_out, w_fft_out, w_mix_out, g_ffn2, w_ffn2_in, w_ffn2_out, g_final):
    for l in range(DEPTH):
        x = x + 0.5 * _swiglu(_rmsnorm(x, g_ffn1[l]), w_ffn1_in[l], w_ffn1_out[l])
        x = x + _mixer(_rmsnorm(x, g_mix[l]), w_in[l], ret_log_decay_fwd[l], ret_log_decay_bwd[l],
                       w_ret_out[l], w_fft_out[l], w_mix_out[l])
        x = x + 0.5 * _swiglu(_rmsnorm(x, g_ffn2[l]), w_ffn2_in[l], w_ffn2_out[l])
    return _rmsnorm(x, g_final)


def setup_inputs(seed: int = 0) -> dict:
    key = jax.random.key(seed)
    ks = jax.random.split(key, 18)
    f32 = jnp.float32
    nrm = lambda k, shape, scale: jax.random.normal(k, shape, f32) * scale
    base_ld = jnp.log(1.0 - 2.0 ** (-5.0 - jnp.arange(RET_HEADS, dtype=f32)))
    return {
        "x_prompt": nrm(ks[0], (BATCH, SEQ, D_MODEL), 1.0),
        "x_sample": nrm(ks[1], (DEC_BATCH, DEC_SEQ, D_MODEL), 1.0),
        "g_ffn1": 1.0 + nrm(ks[2], (DEPTH, D_MODEL), 0.01),
        "w_ffn1_in": nrm(ks[3], (DEPTH, D_MODEL, 2 * D_FF), D_MODEL ** -0.5),
        "w_ffn1_out": nrm(ks[4], (DEPTH, D_FF, D_MODEL), D_FF ** -0.5),
        "g_mix": 1.0 + nrm(ks[5], (DEPTH, D_MODEL), 0.01),
        "w_in": nrm(ks[6], (DEPTH, D_MODEL, IN_WIDTH), D_MODEL ** -0.5),
        "ret_log_decay_fwd": base_ld[None, :] * (1.0 + nrm(ks[7], (DEPTH, RET_HEADS), 0.05)),
        "ret_log_decay_bwd": base_ld[None, :] * (1.0 + nrm(ks[8], (DEPTH, RET_HEADS), 0.05)),
        "w_ret_out": nrm(ks[9], (DEPTH, RET_WIDTH, D_MODEL), RET_WIDTH ** -0.5),
        "w_fft_out": nrm(ks[10], (DEPTH, FFT_WIDTH, D_MODEL), FFT_WIDTH ** -0.5),
        "w_mix_out": nrm(ks[11], (DEPTH, D_MODEL, D_MODEL), D_MODEL ** -0.5),
        "g_ffn2": 1.0 + nrm(ks[12], (DEPTH, D_MODEL), 0.01),
        "w_ffn2_in": nrm(ks[13], (DEPTH, D_MODEL, 2 * D_FF), D_MODEL ** -0.5),
        "w_ffn2_out": nrm(ks[14], (DEPTH, D_FF, D_MODEL), D_FF ** -0.5),
        "g_final": 1.0 + nrm(ks[15], (D_MODEL,), 0.01),
    }


def reference(x_prompt, x_sample, g_ffn1, w_ffn1_in, w_ffn1_out, g_mix, w_in, ret_log_decay_fwd,
              ret_log_decay_bwd, w_ret_out, w_fft_out, w_mix_out, g_ffn2, w_ffn2_in, w_ffn2_out, g_final):
    y_prompt = _trunk(x_prompt, g_ffn1, w_ffn1_in, w_ffn1_out, g_mix, w_in, ret_log_decay_fwd,
                      ret_log_decay_bwd, w_ret_out, w_fft_out, w_mix_out, g_ffn2, w_ffn2_in, w_ffn2_out, g_final)
    y_sample = _trunk(x_sample, g_ffn1, w_ffn1_in, w_ffn1_out, g_mix, w_in, ret_log_decay_fwd,
                      ret_log_decay_bwd, w_ret_out, w_fft_out, w_mix_out, g_ffn2, w_ffn2_in, w_ffn2_out, g_final)
    return (y_prompt, y_sample)
```

```cpp
#include <hip/hip_runtime.h>
#include <hip/hip_cooperative_groups.h>
#include <cstdio>
#include <cstdint>
namespace cg = cooperative_groups;
#ifndef MK_ONE_LAUNCH
#define MK_ONE_LAUNCH 1
#endif
#define SKIP_FFT 0
#define OUT_SCALE 1.0f
#ifndef GEMM_ALIGN
#define GEMM_ALIGN true
#endif
#ifndef GEMM_SP2
#define GEMM_SP2 true
#endif
#ifndef RES_ALIGN
#define RES_ALIGN true
#endif
#ifndef SWI_ALIGN
#define SWI_ALIGN true
#endif
#ifndef WGM_SET
#define WGM_SET 4
#endif
#ifndef BF_ALIGN
#define BF_ALIGN false
#endif
namespace pg8 {
#define PG8_LAS __attribute__((address_space(3)))
typedef unsigned short bf16_t;
typedef short bf16x8 __attribute__((ext_vector_type(8)));
typedef float f32x4 __attribute__((ext_vector_type(4)));
typedef unsigned u32x4 __attribute__((ext_vector_type(4)));
constexpr int BM = 256, BK = 64, HALF = 128, HTB = HALF * BK * 2  , STAGE_BYTES = 8 * HTB, NXCD = 8, WGM = WGM_SET;

__host__ __device__ __forceinline__ int lds_byte(int r, int c) { const int st = (r >> 4) * 2 + (c >> 5), rr = r & 15, cc = c & 31, ob = rr * 64 + cc * 2; return st * 1024 + (ob ^ (((ob >> 9) & 1) << 5)); }
__host__ __device__ __forceinline__ void stage_rc(int b, int& R, int& C) { const int st = b / 1024, sb = b % 1024, swz = sb ^ (((sb >> 9) & 1) << 5); R = (st >> 1) * 16 + swz / 64; C = (st & 1) * 32 + (swz % 64) / 2; }
__host__ __device__ __forceinline__ int perm32(int rho) { const int n = rho >> 4, i = rho & 15; return 8 * (i >> 2) + 4 * n + (i & 3); }

struct Unit { int pm, pn; };
struct Gemm { const bf16_t* A; const bf16_t* Bt; int M, N, K; };

struct StaticOrder {
    int nM, nN, nwg, G, c;
    __host__ __device__ void init(int M, int N, int G_, int c_) { nM = M / BM; nN = N / BM; nwg = nM * nN; G = G_; c = c_; }
    __host__ __device__ bool next(int i, Unit& u) const {
        const long L = (long)i * G + c; if (L >= nwg) return false;
        int wgid = (int)L; { const int q = nwg / NXCD, r = nwg % NXCD, xcd = wgid % NXCD, off = wgid / NXCD; wgid = (xcd < r ? xcd * (q + 1) : r * (q + 1) + (xcd - r) * q) + off; }
        const int nig = WGM * nN, gid = wgid / nig, fm = gid * WGM, gsz = (nM - fm) < WGM ? (nM - fm) : WGM;
        u.pm = fm + ((wgid % nig) % gsz); u.pn = (wgid % nig) / gsz; return true;
    }
    __device__ __forceinline__ void a_ready(const Unit&) const {}
    __device__ __forceinline__ void done(const Unit&) const {}
};
typedef __bf16 bf16v2_t __attribute__((ext_vector_type(2)));
typedef float f32v2_t __attribute__((ext_vector_type(2)));
__device__ __forceinline__ unsigned cvt_pk_bf16(float lo, float hi) { const f32v2_t v = {lo, hi}; const bf16v2_t r = __builtin_convertvector(v, bf16v2_t); return __builtin_bit_cast(unsigned, r); }
template <class Epi, class Sched, bool ALIGN_EPI = false, bool SP2 = false>
__device__ __forceinline__ void gemm_phase(PG8_LAS unsigned char* lds, const Gemm g, const Sched& S, const Epi& E) {
    int tid_ = threadIdx.x; asm volatile("" : "+v"(tid_)); const int tid = tid_, wid = __builtin_amdgcn_readfirstlane(tid >> 6), lane = tid & 63, wr = wid >> 2, wc = wid & 3, fr = lane & 15, fq = lane >> 4;
    const int K = g.K, nt = K / BK;
    unsigned voffA[2], voffB[2];
#pragma unroll
    for (int i = 0; i < 2; ++i) { int R, C; stage_rc(tid * 16 + i * 8192, R, C); const int Rb = Epi::PERM ? ((R & ~31) + perm32(R & 31)) : R;
        voffA[i] = (unsigned)(R * K + C) * 2u; voffB[i] = (unsigned)(Rb * K + C) * 2u; }
    const size_t kstep = (size_t)(BK * 2);
    const size_t hstep = (size_t)HALF * K * 2;
    const size_t tstep = 2 * hstep;
    const unsigned ldsw = (unsigned)wid * 1024u;
    const int aoff = lds_byte(wr * 64 + fr, fq * 8), boff = lds_byte(wc * 32 + fr, fq * 8);
#define PG8_SA(b, h) (((b) * 2 + (h)) * HTB)
#define PG8_SB(b, h) ((4 + (b) * 2 + (h)) * HTB)
#define PG8_STAGE(bufoff, gbase, voff) do { _Pragma("unroll") for (int _i = 0; _i < 2; ++_i) \
        __builtin_amdgcn_global_load_lds((const unsigned*)((const char*)(gbase) + (voff)[_i]), (PG8_LAS unsigned*)(lds + (bufoff) + ldsw + _i * 8192), 16, 0, 0); } while (0)
#define PG8_LDA(dst, b, h) do { _Pragma("unroll") for (int m = 0; m < 4; ++m) _Pragma("unroll") for (int k = 0; k < 2; ++k) dst[m][k] = *(const PG8_LAS bf16x8*)(lds + PG8_SA(b, h) + aoff + m * 2048 + k * 1024); } while (0)
#define PG8_LDB(dst, b, h) do { _Pragma("unroll") for (int n = 0; n < 2; ++n) _Pragma("unroll") for (int k = 0; k < 2; ++k) dst[n][k] = *(const PG8_LAS bf16x8*)(lds + PG8_SB(b, h) + boff + n * 2048 + k * 1024); } while (0)
#define PG8_MMA(ai, bj, At, Bt) do { __builtin_amdgcn_s_setprio(1); _Pragma("unroll") for (int m = 0; m < 4; ++m) _Pragma("unroll") for (int n = 0; n < 2; ++n) _Pragma("unroll") for (int k = 0; k < 2; ++k) \
        acc[ai][bj][m][n] = __builtin_amdgcn_mfma_f32_16x16x32_bf16(Bt[n][k], At[m][k], acc[ai][bj][m][n], 0, 0, 0); __builtin_amdgcn_s_setprio(0); } while (0)
#define PG8_WAIT_V(n) asm volatile("s_waitcnt vmcnt(" #n ")" ::: "memory")
#define PG8_WAIT_L(n) asm volatile("s_waitcnt lgkmcnt(" #n ")" ::: "memory")
#define PG8_BAR __builtin_amdgcn_s_barrier()
#define PG8_SCHED __builtin_amdgcn_sched_barrier(0)
    Unit cur, nxt; int ui = 0;
    if (!S.next(0, cur)) return;
    f32x4 acc[2][2][4][2];
#pragma unroll
    for (int a = 0; a < 2; ++a)
#pragma unroll
        for (int b = 0; b < 2; ++b)
#pragma unroll
            for (int m = 0; m < 4; ++m)
#pragma unroll
                for (int n = 0; n < 2; ++n) acc[a][b][m][n] = (f32x4){0.f, 0.f, 0.f, 0.f};
    bf16x8 At[4][2], B0[2][2], B1[2][2];
    const char* cA = (const char*)g.A + (size_t)cur.pm * tstep; const char* cB = (const char*)g.Bt + (size_t)cur.pn * tstep;
    S.a_ready(cur);
    if constexpr (SP2) {
        PG8_STAGE(PG8_SB(0, 0), cB, voffB); PG8_STAGE(PG8_SB(0, 1), cB + hstep, voffB); PG8_STAGE(PG8_SA(0, 0), cA, voffA); PG8_STAGE(PG8_SA(0, 1), cA + hstep, voffA);
        if (wr == 1) PG8_BAR;
        PG8_WAIT_V(2); PG8_BAR;
        PG8_STAGE(PG8_SB(1, 0), cB + kstep, voffB); PG8_STAGE(PG8_SA(1, 0), cA + kstep, voffA); PG8_STAGE(PG8_SB(1, 1), cB + hstep + kstep, voffB);
        PG8_WAIT_V(6); PG8_BAR;
    } else {
        PG8_STAGE(PG8_SB(0, 0), cB, voffB); PG8_STAGE(PG8_SA(0, 0), cA, voffA); PG8_STAGE(PG8_SB(0, 1), cB + hstep, voffB); PG8_STAGE(PG8_SA(0, 1), cA + hstep, voffA);
        if (wr == 1) PG8_BAR;
        PG8_WAIT_V(4); PG8_BAR;
        PG8_STAGE(PG8_SB(1, 0), cB + kstep, voffB); PG8_STAGE(PG8_SA(1, 0), cA + kstep, voffA); PG8_STAGE(PG8_SB(1, 1), cB + hstep + kstep, voffB);
        PG8_WAIT_V(6); PG8_BAR;
    }
    for (;;) {
        const bool has_next = S.next(ui + 1, nxt);
        const char* nA = has_next ? (const char*)g.A + (size_t)nxt.pm * tstep : cA; const char* nB = has_next ? (const char*)g.Bt + (size_t)nxt.pn * tstep : cB;
        for (int t = 0; t < nt; t += 2) {
            const bool last = (t == nt - 2);
            const char* a1 = cA + (size_t)(t + 1) * kstep;
            const char* a2 = last ? nA : cA + (size_t)(t + 2) * kstep; const char* b2 = last ? nB : cB + (size_t)(t + 2) * kstep;
            const char* a3 = a2 + kstep; const char* b3 = b2 + kstep;
            if (last && has_next) S.a_ready(nxt);
            if constexpr (SP2) {
            PG8_LDB(B0, 0, 0); PG8_LDB(B1, 0, 1); PG8_SCHED; PG8_LDA(At, 0, 0); PG8_STAGE(PG8_SA(1, 1), a1 + hstep, voffA);
            PG8_WAIT_V(8); PG8_WAIT_L(0); PG8_BAR; PG8_MMA(0, 0, At, B0); PG8_MMA(0, 1, At, B1); PG8_BAR; PG8_SCHED;
            PG8_LDA(At, 0, 1); PG8_STAGE(PG8_SB(0, 0), b2, voffB); PG8_STAGE(PG8_SB(0, 1), b2 + hstep, voffB); PG8_STAGE(PG8_SA(0, 0), a2, voffA);
            PG8_WAIT_V(8); PG8_WAIT_L(0); PG8_BAR; PG8_MMA(1, 0, At, B0); PG8_MMA(1, 1, At, B1); PG8_BAR; PG8_SCHED;
            PG8_LDB(B0, 1, 0); PG8_LDB(B1, 1, 1); PG8_SCHED; PG8_LDA(At, 1, 0); PG8_STAGE(PG8_SA(0, 1), a2 + hstep, voffA);
            PG8_WAIT_V(8); PG8_WAIT_L(0); PG8_BAR; PG8_MMA(0, 0, At, B0); PG8_MMA(0, 1, At, B1); PG8_BAR; PG8_SCHED;
            PG8_LDA(At, 1, 1); PG8_STAGE(PG8_SB(1, 0), b3, voffB); PG8_STAGE(PG8_SB(1, 1), b3 + hstep, voffB); PG8_STAGE(PG8_SA(1, 0), a3, voffA);
            PG8_WAIT_V(8); PG8_WAIT_L(0); PG8_BAR; PG8_MMA(1, 0, At, B0); PG8_MMA(1, 1, At, B1); PG8_BAR; PG8_SCHED;
            } else {
            PG8_LDB(B0, 0, 0); PG8_SCHED; PG8_LDA(At, 0, 0); PG8_STAGE(PG8_SA(1, 1), a1 + hstep, voffA);
            PG8_WAIT_L(8); PG8_BAR; PG8_WAIT_L(0); PG8_MMA(0, 0, At, B0); PG8_BAR; PG8_SCHED;
            PG8_LDB(B1, 0, 1); PG8_STAGE(PG8_SB(0, 0), b2, voffB);
            PG8_BAR; PG8_WAIT_L(0); PG8_MMA(0, 1, At, B1); PG8_BAR;
            PG8_LDA(At, 0, 1); PG8_STAGE(PG8_SA(0, 0), a2, voffA);
            PG8_BAR; PG8_WAIT_L(0); PG8_MMA(1, 0, At, B0); PG8_BAR; PG8_SCHED;
            PG8_STAGE(PG8_SB(0, 1), b2 + hstep, voffB);
            PG8_WAIT_V(6); PG8_BAR; PG8_MMA(1, 1, At, B1); PG8_BAR;
            PG8_LDB(B0, 1, 0); PG8_SCHED; PG8_LDA(At, 1, 0); PG8_STAGE(PG8_SA(0, 1), a2 + hstep, voffA);
            PG8_WAIT_L(8); PG8_BAR; PG8_WAIT_L(0); PG8_MMA(0, 0, At, B0); PG8_BAR; PG8_SCHED;
            PG8_LDB(B1, 1, 1); PG8_STAGE(PG8_SB(1, 0), b3, voffB);
            PG8_BAR; PG8_WAIT_L(0); PG8_MMA(0, 1, At, B1); PG8_BAR;
            PG8_LDA(At, 1, 1); PG8_STAGE(PG8_SA(1, 0), a3, voffA);
            PG8_BAR; PG8_WAIT_L(0); PG8_MMA(1, 0, At, B0); PG8_BAR; PG8_SCHED;
            PG8_STAGE(PG8_SB(1, 1), b3 + hstep, voffB);
            PG8_WAIT_V(6); PG8_BAR; PG8_MMA(1, 1, At, B1); PG8_BAR;
            }
        }
        if constexpr (ALIGN_EPI) { if (wr == 0) PG8_BAR; }
        if constexpr (!Epi::AFTER_DRAIN) { E(acc, cur, wr, wc, fr, fq); S.done(cur); }
        if (!has_next) break;
#pragma unroll
        for (int a = 0; a < 2; ++a)
#pragma unroll
            for (int b = 0; b < 2; ++b)
#pragma unroll
                for (int m = 0; m < 4; ++m)
#pragma unroll
                    for (int n = 0; n < 2; ++n) acc[a][b][m][n] = (f32x4){0.f, 0.f, 0.f, 0.f};
        cur = nxt; cA = nA; cB = nB; ++ui;
        if constexpr (ALIGN_EPI) { if (wr == 1) PG8_BAR; }
    }
    PG8_WAIT_V(0);
    if constexpr (!ALIGN_EPI) { if (wr == 0) PG8_BAR; }
    PG8_BAR;
    if constexpr (Epi::AFTER_DRAIN) { E.fused(acc, cur, wr, wc, fr, fq, lds, wid, lane); S.done(cur); }
#undef PG8_SA
#undef PG8_SB
#undef PG8_STAGE
#undef PG8_LDA
#undef PG8_LDB
#undef PG8_MMA
#undef PG8_WAIT_V
#undef PG8_WAIT_L
#undef PG8_BAR
#undef PG8_SCHED
}
}
#define XB_TMO      128
#define XB_XCNT(j)  (256  + 64 * (j))
#define XB_XSUB(j)  (1280 + 64 * (j))
#define XB_XGEN(j)  (2304 + 64 * (j))
#define XB_TOP      3328
#define XB_TOPGEN   3392
#define XCD_BAR_WORDS 3456
#define XB_SPIN_CAP (1u << 18)
#define LAS __attribute__((address_space(3)))

__device__ __forceinline__ unsigned xb_ld(unsigned* p)              { return __hip_atomic_load(p, __ATOMIC_RELAXED, __HIP_MEMORY_SCOPE_AGENT); }
__device__ __forceinline__ unsigned xb_add(unsigned* p, unsigned v) { return __hip_atomic_fetch_add(p, v, __ATOMIC_RELAXED, __HIP_MEMORY_SCOPE_AGENT); }
__device__ __forceinline__ unsigned xb_xcc_id() { return (unsigned)__builtin_amdgcn_s_getreg((3 << 11) | 20) & 0xFu; }
#define XB_SPIN(cond, bar) do { unsigned _sp = 0; while (cond) { __builtin_amdgcn_s_sleep(1); \
    if ((++_sp & 255u) == 0u) { if (xb_ld(&(bar)[XB_TMO])) break; if (_sp > XB_SPIN_CAP) { atomicAdd(&(bar)[XB_TMO], 1u); break; } } } } while (0)

struct XcdBarrier {
    unsigned* bar; unsigned x;
    volatile LAS unsigned* st;
};

__device__ __forceinline__ XcdBarrier xcd_barrier_post(unsigned* bar, volatile LAS unsigned* st) {
    XcdBarrier b; b.bar = bar; b.x = xb_xcc_id(); b.st = st;
    if (threadIdx.x == 0) (void)xb_add(&bar[XB_XCNT(b.x)], 1u);
    return b;
}
__device__ __forceinline__ void xcd_barrier_complete(unsigned* bar, unsigned x, unsigned& nloc, unsigned& nx) {
    const unsigned G = gridDim.x * gridDim.y * gridDim.z;
    unsigned sum, cnt, mine, sp = 0u;
    for (;;) {
        sum = 0u; cnt = 0u; mine = 0u;
#pragma unroll
        for (unsigned j = 0; j < 16; ++j) { const unsigned c = xb_ld(&bar[XB_XCNT(j)]); sum += c; cnt += (c > 0u) ? 1u : 0u; mine = (j == x) ? c : mine; }
        if (sum == G) break;
        __builtin_amdgcn_s_sleep(1);
        if ((++sp & 255u) == 0u) { if (xb_ld(&bar[XB_TMO])) break; if (sp > XB_SPIN_CAP) { atomicAdd(&bar[XB_TMO], 1u); break; } }
    }
    nloc = mine > 0u ? mine : 1u; nx = cnt > 0u ? cnt : 1u;
}

__device__ __forceinline__ void xcd_barrier(const XcdBarrier& b) {
    asm volatile("s_waitcnt vmcnt(0)" ::: "memory");
    __syncthreads();
    if (threadIdx.x == 0) {
        unsigned* bar = b.bar;
        __builtin_amdgcn_s_waitcnt(0);
        unsigned nloc = b.st[0], nx = b.st[1];
        if (nloc == 0u) { xcd_barrier_complete(bar, b.x, nloc, nx); b.st[0] = nloc; b.st[1] = nx; }
        const unsigned old = xb_add(&bar[XB_XSUB(b.x)], 1u);
        const unsigned gen = old / nloc;
        if (old + 1u == (gen + 1u) * nloc) {
            __builtin_amdgcn_fence(__ATOMIC_RELEASE, "agent");
            asm volatile("s_waitcnt vmcnt(0)" ::: "memory");
            const unsigned og = xb_add(&bar[XB_TOP], 1u);
            const unsigned tg = og / nx;
            if (og + 1u == (tg + 1u) * nx) xb_add(&bar[XB_TOPGEN], 1u);
            else XB_SPIN(xb_ld(&bar[XB_TOPGEN]) == tg, bar);
            __builtin_amdgcn_fence(__ATOMIC_ACQUIRE, "agent");
            xb_add(&bar[XB_XGEN(b.x)], 1u);
            asm volatile("s_waitcnt vmcnt(0)" ::: "memory");
        } else {
            XB_SPIN(xb_ld(&bar[XB_XGEN(b.x)]) == gen, bar);
            __builtin_amdgcn_fence(__ATOMIC_ACQUIRE, "agent");
            asm volatile("s_waitcnt vmcnt(0)" ::: "memory");
        }
    }
    __syncthreads();
}


using pg8::bf16_t; using pg8::bf16x8; using pg8::f32x4; using pg8::u32x4; using pg8::cvt_pk_bf16;
typedef unsigned u32x2 __attribute__((ext_vector_type(2)));
typedef float f32x2v __attribute__((ext_vector_type(2)));

constexpr int HT = 32768;
constexpr size_t MiB = 1ull << 20;
constexpr size_t WS_W = 0, WS_ROPE = 46 * MiB, WS_XB = 54 * MiB, WS_HB = 182 * MiB, HB_STRIDE = 160 * MiB, WS_U0 = 182 * MiB, WS_CTL = 502 * MiB, WS_RS = 503 * MiB, WS_SS = 504 * MiB, WS_END = 508 * MiB;
constexpr size_t HB_Q = 0, HB_K = 32 * MiB, HB_V = 64 * MiB, HB_SG = 96 * MiB, HB_F = 128 * MiB, HB_RET = HB_K;
constexpr size_t DO_STRIDE = 128 * MiB, DO_KVF = 0, DO_KVB = 32 * MiB, DO_APR = 64 * MiB, DO_API = 96 * MiB, DO_MRG = 0, DO_FOU = 64 * MiB, DO_U1 = 0;
constexpr size_t WO_F1I = 0, WO_F1O = WO_F1I + 5632ull * 1024, WO_WIN = WO_F1O + 1024ull * 2816, WO_RET = WO_WIN + 4608ull * 1024, WO_FFT = WO_RET + 1024ull * 512,
    WO_MIX = WO_FFT + 1024ull * 512, WO_F2I = WO_MIX + 1024ull * 1024, WO_F2O = WO_F2I + 5632ull * 1024, WO_LAYER = WO_F2O + 1024ull * 2816;
constexpr int LDS_TILES = 4 * 34816;
constexpr int LDS_BYTES = LDS_TILES + 16;
constexpr int TP = 272, TREG = 128 * TP;
constexpr float LOG2E = 1.4426950408889634f;
constexpr int NPHASES = 30;

struct Params { const float* in[16]; float* out; unsigned char* ws; int ph_lo, ph_hi; };
#define AS4 __attribute__((address_space(4)))
struct PRef {
    const AS4 Params* kp;
    __device__ __forceinline__ const float* in(int i) const { return kp->in[i]; }
    __device__ __forceinline__ float* out() const { return kp->out; }
    __device__ __forceinline__ unsigned char* ws() const { return kp->ws; }
};

__device__ __forceinline__ float wave_sum(float v) {
#pragma unroll
    for (int o = 1; o < 64; o <<= 1) v += __shfl_xor(v, o);
    return v;
}
__device__ __forceinline__ float silu_f(float x) { return x * __builtin_amdgcn_rcpf(1.0f + __builtin_amdgcn_exp2f(-x * LOG2E)); }
__device__ __forceinline__ float sigm_f(float x) { return __builtin_amdgcn_rcpf(1.0f + __builtin_amdgcn_exp2f(-x * LOG2E)); }
__device__ __forceinline__ float bflo(unsigned w) { return __uint_as_float(w << 16); }
__device__ __forceinline__ float bfhi(unsigned w) { return __uint_as_float(w & 0xffff0000u); }
#define LDS_WAIT() asm volatile("s_waitcnt lgkmcnt(0)" ::: "memory")

__device__ __forceinline__ float sumsq8(const u32x4 v);
struct EpiSwiGLU {
    static constexpr bool PERM = true, AFTER_DRAIN = false;
    bf16_t* U; const float* rs;
    __device__ __forceinline__ void operator()(const f32x4 (&acc)[2][2][4][2], const pg8::Unit& u, int wr, int wc, int fr, int fq) const {
        const int row0 = u.pm * 256 + wr * 64 + fr, col0 = u.pn * 128 + wc * 32 + 8 * fq;
        float rr[2][4];
#pragma unroll
        for (int ai = 0; ai < 2; ++ai)
#pragma unroll
            for (int m = 0; m < 4; ++m) rr[ai][m] = rs[row0 + ai * 128 + m * 16];
#pragma unroll
        for (int ai = 0; ai < 2; ++ai)
#pragma unroll
            for (int m = 0; m < 4; ++m) {
                bf16_t* p = U + (size_t)(row0 + ai * 128 + m * 16) * 2816 + col0;
                const float r = rr[ai][m];
                const f32x4 a0 = acc[ai][0][m][0] * r, a1 = acc[ai][0][m][1] * r, b0 = acc[ai][1][m][0] * r, b1 = acc[ai][1][m][1] * r;
                u32x4 w;
                w.x = cvt_pk_bf16(silu_f(a0[0]) * b0[0], silu_f(a0[1]) * b0[1]); w.y = cvt_pk_bf16(silu_f(a0[2]) * b0[2], silu_f(a0[3]) * b0[3]);
                w.z = cvt_pk_bf16(silu_f(a1[0]) * b1[0], silu_f(a1[1]) * b1[1]); w.w = cvt_pk_bf16(silu_f(a1[2]) * b1[2], silu_f(a1[3]) * b1[3]);
                *(u32x4*)p = w;
            }
    }
};
struct EpiRes {
    static constexpr bool PERM = true, AFTER_DRAIN = false;
    bf16_t* X; float* ss; float scale;
    __device__ __forceinline__ void operator()(const f32x4 (&acc)[2][2][4][2], const pg8::Unit& u, int wr, int wc, int fr, int fq) const {
        const int row0 = u.pm * 256 + wr * 64 + fr, col0 = u.pn * 256 + wc * 32 + 8 * fq;
#pragma unroll
        for (int ai = 0; ai < 2; ++ai) {
            u32x4 xv[4][2];
#pragma unroll
            for (int m = 0; m < 4; ++m)
#pragma unroll
                for (int bj = 0; bj < 2; ++bj) xv[m][bj] = *(const u32x4*)(X + (size_t)(row0 + ai * 128 + m * 16) * 1024 + col0 + bj * 128);
#pragma unroll
            for (int m = 0; m < 4; ++m) {
                float q = 0.f;
#pragma unroll
                for (int bj = 0; bj < 2; ++bj) {
                    const f32x4 v0 = acc[ai][bj][m][0] * scale, v1 = acc[ai][bj][m][1] * scale; const u32x4 x = xv[m][bj];
                    u32x4 w;
                    w.x = cvt_pk_bf16(bflo(x.x) + v0[0], bfhi(x.x) + v0[1]); w.y = cvt_pk_bf16(bflo(x.y) + v0[2], bfhi(x.y) + v0[3]);
                    w.z = cvt_pk_bf16(bflo(x.z) + v1[0], bfhi(x.z) + v1[1]); w.w = cvt_pk_bf16(bflo(x.w) + v1[2], bfhi(x.w) + v1[3]);
                    *(u32x4*)(X + (size_t)(row0 + ai * 128 + m * 16) * 1024 + col0 + bj * 128) = w;
                    q += sumsq8(w);
                }
                q += __shfl_xor(q, 16); q += __shfl_xor(q, 32);
                if (fq == 0) ss[(size_t)(row0 + ai * 128 + m * 16) * 16 + u.pn * 4 + wc] = q;
            }
            asm volatile("" ::: "memory");
        }
    }
};
struct EpiWin {
    static constexpr bool PERM = true, AFTER_DRAIN = false;
    bf16_t* base; const float* rope; const float* rs; int smask;
    __device__ __forceinline__ void operator()(const f32x4 (&acc)[2][2][4][2], const pg8::Unit& u, int wr, int wc, int fr, int fq) const {
        const int pn = u.pn, row0 = u.pm * 256 + wr * 64 + fr;
        if (pn < 4) {
            bf16_t* dstb = base + (size_t)(pn >> 1) * ((size_t)HT * 512);
            const float sc = (pn >> 1) ? 0.08838834764831845f : 1.0f;
            const int head = 2 * (pn & 1) + (wc >> 1), i0 = (wc & 1) * 32 + 8 * fq;
#pragma unroll
            for (int ai = 0; ai < 2; ++ai)
#pragma unroll
                for (int m = 0; m < 4; ++m) {
                    const int row = row0 + ai * 128 + m * 16, pos = row & smask;
                    const f32x4* rp = (const f32x4*)(rope + ((size_t)pos * 64 + i0) * 2);
                    const f32x4 t0 = rp[0], t1 = rp[1], t2 = rp[2], t3 = rp[3];
                    const float scr_ = sc * rs[row];
                    const f32x4 xa = acc[ai][0][m][0] * scr_, xb = acc[ai][0][m][1] * scr_, ya = acc[ai][1][m][0] * scr_, yb = acc[ai][1][m][1] * scr_;
                    u32x4 o1, o2;
                    o1.x = cvt_pk_bf16(xa[0] * t0[0] - ya[0] * t0[1], xa[1] * t0[2] - ya[1] * t0[3]);
                    o1.y = cvt_pk_bf16(xa[2] * t1[0] - ya[2] * t1[1], xa[3] * t1[2] - ya[3] * t1[3]);
                    o1.z = cvt_pk_bf16(xb[0] * t2[0] - yb[0] * t2[1], xb[1] * t2[2] - yb[1] * t2[3]);
                    o1.w = cvt_pk_bf16(xb[2] * t3[0] - yb[2] * t3[1], xb[3] * t3[2] - yb[3] * t3[3]);
                    o2.x = cvt_pk_bf16(xa[0] * t0[1] + ya[0] * t0[0], xa[1] * t0[3] + ya[1] * t0[2]);
                    o2.y = cvt_pk_bf16(xa[2] * t1[1] + ya[2] * t1[0], xa[3] * t1[3] + ya[3] * t1[2]);
                    o2.z = cvt_pk_bf16(xb[0] * t2[1] + yb[0] * t2[0], xb[1] * t2[3] + yb[1] * t2[2]);
                    o2.w = cvt_pk_bf16(xb[2] * t3[1] + yb[2] * t3[0], xb[3] * t3[3] + yb[3] * t3[2]);
                    bf16_t* p = dstb + (size_t)row * 512 + head * 128 + i0;
                    *(u32x4*)p = o1; *(u32x4*)(p + 64) = o2;
                    if (m & 1) asm volatile("" ::: "memory");
                }
        } else {
            const int b = pn >> 1;
            bf16_t* dstb = base + (size_t)b * ((size_t)HT * 512);
            const int col0 = (pn & 1) * 256 + wc * 32 + 8 * fq;
#pragma unroll
            for (int ai = 0; ai < 2; ++ai)
#pragma unroll
                for (int m = 0; m < 4; ++m) {
                    bf16_t* p = dstb + (size_t)(row0 + ai * 128 + m * 16) * 512 + col0;
                    const float r = rs[row0 + ai * 128 + m * 16];
#pragma unroll
                    for (int bj = 0; bj < 2; ++bj) {
                        f32x4 v0 = acc[ai][bj][m][0] * r, v1 = acc[ai][bj][m][1] * r;
                        if (b == 3) {
#pragma unroll
                            for (int j = 0; j < 4; ++j) { v0[j] = silu_f(v0[j]); v1[j] = silu_f(v1[j]); }
                        }
                        u32x4 w; w.x = cvt_pk_bf16(v0[0], v0[1]); w.y = cvt_pk_bf16(v0[2], v0[3]); w.z = cvt_pk_bf16(v1[0], v1[1]); w.w = cvt_pk_bf16(v1[2], v1[3]);
                        *(u32x4*)(p + bj * 128) = w;
                    }
                }
        }
    }
};
struct EpiBf {
    static constexpr bool PERM = true, AFTER_DRAIN = false;
    bf16_t* O;
    __device__ __forceinline__ void operator()(const f32x4 (&acc)[2][2][4][2], const pg8::Unit& u, int wr, int wc, int fr, int fq) const {
        const int row0 = u.pm * 256 + wr * 64 + fr, col0 = u.pn * 256 + wc * 32 + 8 * fq;
#pragma unroll
        for (int ai = 0; ai < 2; ++ai)
#pragma unroll
            for (int m = 0; m < 4; ++m) {
                bf16_t* p = O + (size_t)(row0 + ai * 128 + m * 16) * 1024 + col0;
#pragma unroll
                for (int bj = 0; bj < 2; ++bj) {
                    const f32x4 v0 = acc[ai][bj][m][0], v1 = acc[ai][bj][m][1];
                    u32x4 w; w.x = cvt_pk_bf16(v0[0], v0[1]); w.y = cvt_pk_bf16(v0[2], v0[3]); w.z = cvt_pk_bf16(v1[0], v1[1]); w.w = cvt_pk_bf16(v1[2], v1[3]);
                    *(u32x4*)(p + bj * 128) = w;
                }
            }
    }
};
struct EpiGates {
    static constexpr bool PERM = true, AFTER_DRAIN = false;
    const bf16_t* RET; const bf16_t* FOU; bf16_t* MRG; const float* rs;
    __device__ __forceinline__ void operator()(const f32x4 (&acc)[2][2][4][2], const pg8::Unit& u, int wr, int wc, int fr, int fq) const {
        const int row0 = u.pm * 256 + wr * 64 + fr, col0 = u.pn * 128 + wc * 32 + 8 * fq;
#pragma unroll
        for (int ai = 0; ai < 2; ++ai) {
            u32x4 rv[4], fv[4];
#pragma unroll
            for (int m = 0; m < 4; ++m) { const size_t off = (size_t)(row0 + ai * 128 + m * 16) * 1024 + col0; rv[m] = *(const u32x4*)(RET + off); fv[m] = *(const u32x4*)(FOU + off); }
#pragma unroll
            for (int m = 0; m < 4; ++m) {
                const size_t off = (size_t)(row0 + ai * 128 + m * 16) * 1024 + col0;
                const float r = rs[row0 + ai * 128 + m * 16];
                const f32x4 g0 = acc[ai][0][m][0] * r, g1 = acc[ai][0][m][1] * r, h0 = acc[ai][1][m][0] * r, h1 = acc[ai][1][m][1] * r;
                u32x4 w;
                w.x = cvt_pk_bf16(sigm_f(g0[0]) * bflo(rv[m].x) + sigm_f(h0[0]) * bflo(fv[m].x), sigm_f(g0[1]) * bfhi(rv[m].x) + sigm_f(h0[1]) * bfhi(fv[m].x));
                w.y = cvt_pk_bf16(sigm_f(g0[2]) * bflo(rv[m].y) + sigm_f(h0[2]) * bflo(fv[m].y), sigm_f(g0[3]) * bfhi(rv[m].y) + sigm_f(h0[3]) * bfhi(fv[m].y));
                w.z = cvt_pk_bf16(sigm_f(g1[0]) * bflo(rv[m].z) + sigm_f(h1[0]) * bflo(fv[m].z), sigm_f(g1[1]) * bfhi(rv[m].z) + sigm_f(h1[1]) * bfhi(fv[m].z));
                w.w = cvt_pk_bf16(sigm_f(g1[2]) * bflo(rv[m].w) + sigm_f(h1[2]) * bflo(fv[m].w), sigm_f(g1[3]) * bfhi(rv[m].w) + sigm_f(h1[3]) * bfhi(fv[m].w));
                *(u32x4*)(MRG + off) = w;
            }
            asm volatile("" ::: "memory");
        }
    }
};
template <class Epi, bool ALIGN = GEMM_ALIGN>
__device__ __forceinline__ void run_gemm(LAS unsigned char* lds, const bf16_t* A, const bf16_t* Bt, int M, int N, int K, const Epi& E) {
    pg8::Gemm g; g.A = A; g.Bt = Bt; g.M = M; g.N = N; g.K = K;
    pg8::StaticOrder S; S.init(M, N, (int)gridDim.x, (int)blockIdx.x);
    pg8::gemm_phase<Epi, pg8::StaticOrder, ALIGN, GEMM_SP2>(lds, g, S, E);
    __syncthreads();
}

__device__ __forceinline__ int src_col(int kind, int n) {
    if (kind == 0) return n;
    const int t = n >> 8, r = n & 255;
    if (kind == 1) return (r < 128) ? (t * 128 + r) : (2816 + t * 128 + (r - 128));
    if (t < 4) { const int hi = r >> 7, rr = r & 127, hl = rr >> 6, i = rr & 63, head = 2 * (t & 1) + hl; return (t >> 1) * 512 + head * 128 + 2 * i + hi; }
    if (t < 10) return n;
    const int tg = t - 10; return (r < 128) ? (2560 + tg * 128 + r) : (3584 + tg * 128 + (r - 128));
}
__device__ __forceinline__ void transpose_item(const float* W, int K, int N, bf16_t* WT, int kind, LAS float* scr, int item, int lane, const float* g = nullptr) {
    const int nblk = N / 32, kb = item / nblk, nb = item % nblk, k0 = 64 * kb, n0 = 32 * nb;
    const int sc = src_col(kind, n0 + (lane & 31));
#pragma unroll 8
    for (int i = 0; i < 32; ++i) { const int kk = 2 * i + (lane >> 5); float w = W[(size_t)(k0 + kk) * N + sc]; if (g) w *= g[k0 + kk]; scr[kk * 33 + (lane & 31)] = w; }
    LDS_WAIT();
    const int c = lane & 7;
#pragma unroll
    for (int j = 0; j < 4; ++j) {
        const int n = (lane >> 3) + 8 * j; const LAS float* s = scr + (8 * c) * 33 + n;
        u32x4 o; o.x = cvt_pk_bf16(s[0 * 33], s[1 * 33]); o.y = cvt_pk_bf16(s[2 * 33], s[3 * 33]); o.z = cvt_pk_bf16(s[4 * 33], s[5 * 33]); o.w = cvt_pk_bf16(s[6 * 33], s[7 * 33]);
        *(u32x4*)(WT + (size_t)(n0 + n) * K + k0 + 8 * c) = o;
    }
    LDS_WAIT();
}
__device__ __forceinline__ void phase_prep(const PRef& p, LAS unsigned char* lds, int l, int grp) {
    int tid_ = threadIdx.x; asm volatile("" : "+v"(tid_)); const int tid = tid_, wave = tid >> 6, lane = tid & 63;
    LAS float* scr = (LAS float*)(lds + wave * 8448);
    bf16_t* W = (bf16_t*)(p.ws() + WS_W);
    const int gw = blockIdx.x * 8 + wave, ngw = gridDim.x * 8;
    constexpr int I_FI = 16 * 176, I_FO = 44 * 32, I_WIN = 16 * 144, I_RO = 8 * 32, I_MX = 16 * 32, I_LAYER = 2 * I_FI + 2 * I_FO + I_WIN + 2 * I_RO + I_MX;
    constexpr int I_A = I_FI + I_FO + I_WIN + 2 * I_RO + I_MX;
    const int it0 = (grp & 1) ? 0 : I_A, it1 = (grp & 2) ? I_LAYER : I_A;
    for (int it = it0 + gw; it < it1; it += ngw) {
        int r = it;
        bf16_t* Wl = W;
        if (r < I_FI) { transpose_item(p.in(3) + (size_t)l * 1024 * 5632, 1024, 5632, Wl + WO_F1I, 1, scr, r, lane, p.in(2) + l * 1024); continue; } r -= I_FI;
        if (r < I_FO) { transpose_item(p.in(4) + (size_t)l * 2816 * 1024, 2816, 1024, Wl + WO_F1O, 0, scr, r, lane); continue; } r -= I_FO;
        if (r < I_WIN) { transpose_item(p.in(6) + (size_t)l * 1024 * 4608, 1024, 4608, Wl + WO_WIN, 2, scr, r, lane, p.in(5) + l * 1024); continue; } r -= I_WIN;
        if (r < I_RO) { transpose_item(p.in(9) + (size_t)l * 512 * 1024, 512, 1024, Wl + WO_RET, 0, scr, r, lane); continue; } r -= I_RO;
        if (r < I_RO) { transpose_item(p.in(10) + (size_t)l * 512 * 1024, 512, 1024, Wl + WO_FFT, 0, scr, r, lane); continue; } r -= I_RO;
        if (r < I_MX) { transpose_item(p.in(11) + (size_t)l * 1024 * 1024, 1024, 1024, Wl + WO_MIX, 0, scr, r, lane); continue; } r -= I_MX;
        if (r < I_FI) { transpose_item(p.in(13) + (size_t)l * 1024 * 5632, 1024, 5632, Wl + WO_F2I, 1, scr, r, lane, p.in(12) + l * 1024); continue; } r -= I_FI;
        transpose_item(p.in(14) + (size_t)l * 2816 * 1024, 2816, 1024, Wl + WO_F2O, 0, scr, r, lane);
    }
    if (!(grp & 4)) return;
    f32x2v* rope = (f32x2v*)(p.ws() + WS_ROPE);
    for (int idx = blockIdx.x * 512 + tid; idx < 16384 * 64; idx += gridDim.x * 512) {
        const int pos = idx >> 6, i = idx & 63;
        double f = 1.0;
        for (int q = 0; q < i; ++q) f *= 0.8639884494839686;
        const float inv = (float)f, ang = (float)pos * inv;
        double rev = (double)ang * 0.15915494309189535; rev -= __builtin_floor(rev);
        const float fr = (float)rev;
        f32x2v o; o.x = __builtin_amdgcn_cosf(fr); o.y = __builtin_amdgcn_sinf(fr);
        rope[idx] = o;
    }
}

__device__ __forceinline__ void rows_init(const float* src, bf16_t* xb, float* rs, int nrows) {
    int tid_ = threadIdx.x; asm volatile("" : "+v"(tid_)); const int tid = tid_, wave = tid >> 6, lane = tid & 63;
    for (int row = blockIdx.x * 8 + wave; row < nrows; row += gridDim.x * 8) {
        const f32x4* xr = (const f32x4*)(src + (size_t)row * 1024) + lane;
        const f32x4 v0 = xr[0], v1 = xr[64], v2 = xr[128], v3 = xr[192];
        float s = (v0[0] * v0[0] + v0[1] * v0[1]) + (v0[2] * v0[2] + v0[3] * v0[3]);
        s += (v1[0] * v1[0] + v1[1] * v1[1]) + (v1[2] * v1[2] + v1[3] * v1[3]);
        s += (v2[0] * v2[0] + v2[1] * v2[1]) + (v2[2] * v2[2] + v2[3] * v2[3]);
        s += (v3[0] * v3[0] + v3[1] * v3[1]) + (v3[2] * v3[2] + v3[3] * v3[3]);
        const float rstd = 1.0f / sqrtf(wave_sum(s) * (1.0f / 1024.0f) + 1e-6f);
        if (lane == 0) rs[row] = rstd;
        u32x2* o = (u32x2*)(xb + (size_t)row * 1024) + lane;
        u32x2 w; w.x = cvt_pk_bf16(v0[0], v0[1]); w.y = cvt_pk_bf16(v0[2], v0[3]); o[0] = w;
        w.x = cvt_pk_bf16(v1[0], v1[1]); w.y = cvt_pk_bf16(v1[2], v1[3]); o[64] = w;
        w.x = cvt_pk_bf16(v2[0], v2[1]); w.y = cvt_pk_bf16(v2[2], v2[3]); o[128] = w;
        w.x = cvt_pk_bf16(v3[0], v3[1]); w.y = cvt_pk_bf16(v3[2], v3[3]); o[192] = w;
    }
}
__device__ __forceinline__ float sumsq8(const u32x4 v) {
    return (bflo(v.x) * bflo(v.x) + bfhi(v.x) * bfhi(v.x)) + (bflo(v.y) * bflo(v.y) + bfhi(v.y) * bfhi(v.y)) + (bflo(v.z) * bflo(v.z) + bfhi(v.z) * bfhi(v.z)) + (bflo(v.w) * bflo(v.w) + bfhi(v.w) * bfhi(v.w));
}
__device__ __forceinline__ void rowstat(const bf16_t* xb, float* rs, int nrows) {
    int tid_ = threadIdx.x; asm volatile("" : "+v"(tid_)); const int tid = tid_, wave = tid >> 6, lane = tid & 63;
    for (int row0 = (blockIdx.x * 8 + wave) * 2; row0 < nrows; row0 += gridDim.x * 16) {
        const u32x4* r0 = (const u32x4*)(xb + (size_t)row0 * 1024) + lane;
        const u32x4 a0 = r0[0], a1 = r0[64], b0 = r0[128], b1 = r0[192];
        const float s0 = wave_sum(sumsq8(a0) + sumsq8(a1)), s1 = wave_sum(sumsq8(b0) + sumsq8(b1));
        if (lane == 0) { rs[row0] = 1.0f / sqrtf(s0 * (1.0f / 1024.0f) + 1e-6f); rs[row0 + 1] = 1.0f / sqrtf(s1 * (1.0f / 1024.0f) + 1e-6f); }
    }
}
__device__ __forceinline__ void rowstat_slots(const float* ss, float* rs, int nrows) {
    int tid_ = threadIdx.x; asm volatile("" : "+v"(tid_));
    for (int row = blockIdx.x * 512 + tid_; row < nrows; row += gridDim.x * 512) {
        const f32x4* p4 = (const f32x4*)(ss + (size_t)row * 16);
        const f32x4 a = p4[0], b = p4[1], c = p4[2], d = p4[3];
        const float s = ((a[0] + a[1]) + (a[2] + a[3])) + ((b[0] + b[1]) + (b[2] + b[3])) + ((c[0] + c[1]) + (c[2] + c[3])) + ((d[0] + d[1]) + (d[2] + d[3]));
        rs[row] = 1.0f / sqrtf(s * (1.0f / 1024.0f) + 1e-6f);
    }
}
__device__ __forceinline__ void final_norm(const bf16_t* xb, const float* g, float* out, int nrows) {
    int tid_ = threadIdx.x; asm volatile("" : "+v"(tid_)); const int tid = tid_, wave = tid >> 6, lane = tid & 63;
    const f32x4* gp = (const f32x4*)g + 2 * lane;
    const f32x4 g0 = gp[0], g1 = gp[1], g2 = gp[128], g3 = gp[129];
    for (int row = blockIdx.x * 8 + wave; row < nrows; row += gridDim.x * 8) {
        const u32x4* r0 = (const u32x4*)(xb + (size_t)row * 1024) + lane;
        const u32x4 a = r0[0], b = r0[64];
        const float rstd = 1.0f / sqrtf(wave_sum(sumsq8(a) + sumsq8(b)) * (1.0f / 1024.0f) + 1e-6f);
        f32x4* o = (f32x4*)(out + (size_t)row * 1024) + 2 * lane;
        o[0] = (f32x4){bflo(a.x), bfhi(a.x), bflo(a.y), bfhi(a.y)} * rstd * g0; o[1] = (f32x4){bflo(a.z), bfhi(a.z), bflo(a.w), bfhi(a.w)} * rstd * g1;
        o[128] = (f32x4){bflo(b.x), bfhi(b.x), bflo(b.y), bfhi(b.y)} * rstd * g2; o[129] = (f32x4){bflo(b.z), bfhi(b.z), bflo(b.w), bfhi(b.w)} * rstd * g3;
    }
}

__device__ __forceinline__ void mm_tile(f32x4 (&acc)[2][4], const LAS unsigned char* A, const LAS unsigned char* B, int wr, int wc, int fr, int fq, int ksteps) {
    const LAS unsigned char* ap = A + (32 * wr + fr) * TP + fq * 16;
    const LAS unsigned char* bp = B + (64 * wc + fr) * TP + fq * 16;
    bf16x8 a[2], b[4];
#pragma unroll
    for (int mi = 0; mi < 2; ++mi) a[mi] = *(const LAS bf16x8*)(ap + mi * 16 * TP);
#pragma unroll
    for (int ni = 0; ni < 4; ++ni) b[ni] = *(const LAS bf16x8*)(bp + ni * 16 * TP);
#pragma unroll 1
    for (int ks = 0; ks < ksteps; ++ks) {
        bf16x8 an[2], bn[4];
        const int kn = (ks + 1 < ksteps) ? (ks + 1) : ks;
#pragma unroll
        for (int mi = 0; mi < 2; ++mi) an[mi] = *(const LAS bf16x8*)(ap + mi * 16 * TP + kn * 64);
#pragma unroll
        for (int ni = 0; ni < 4; ++ni) bn[ni] = *(const LAS bf16x8*)(bp + ni * 16 * TP + kn * 64);
#pragma unroll
        for (int mi = 0; mi < 2; ++mi)
#pragma unroll
            for (int ni = 0; ni < 4; ++ni) acc[mi][ni] = __builtin_amdgcn_mfma_f32_16x16x32_bf16(b[ni], a[mi], acc[mi][ni], 0, 0, 0);
#pragma unroll
        for (int mi = 0; mi < 2; ++mi) a[mi] = an[mi];
#pragma unroll
        for (int ni = 0; ni < 4; ++ni) b[ni] = bn[ni];
    }
}
__device__ __forceinline__ void zero_acc(f32x4 (&acc)[2][4]) {
#pragma unroll
    for (int mi = 0; mi < 2; ++mi)
#pragma unroll
        for (int ni = 0; ni < 4; ++ni) acc[mi][ni] = (f32x4){0.f, 0.f, 0.f, 0.f};
}
__device__ __forceinline__ void load_nat(LAS unsigned char* dst, const bf16_t* src, size_t ld, int nrows, int tid) {
    for (int id = tid; id < nrows * 16; id += 512) { const int row = id >> 4, c = id & 15; const u32x4 v = *(const u32x4*)(src + (size_t)row * ld + c * 8); *(LAS u32x4*)(dst + row * TP + c * 16) = v; }
}
__device__ __forceinline__ void tr_issue(u32x4 (&r)[4], const bf16_t* src, size_t ld, int nrows, int tid);
__device__ __forceinline__ void tr_commit(LAS unsigned char* dst, const u32x4 (&r)[4], int nrows, int tid);
__device__ __forceinline__ void load_tr(LAS unsigned char* dst, const bf16_t* src, size_t ld, int nrows, int tid) {
    u32x4 r[4]; tr_issue(r, src, ld, nrows, tid); tr_commit(dst, r, nrows, tid);
}
__device__ __forceinline__ void tr_issue(u32x4 (&r)[4], const bf16_t* src, size_t ld, int nrows, int tid) {
    const int ng = nrows >> 2, g = tid & (ng - 1), c = (nrows == 128) ? (tid >> 5) : (tid >> 4);
    if (c < 16) {
#pragma unroll
        for (int q = 0; q < 4; ++q) r[q] = *(const u32x4*)(src + (size_t)(4 * g + q) * ld + c * 8);
    }
}
__device__ __forceinline__ void tr_commit(LAS unsigned char* dst, const u32x4 (&r)[4], int nrows, int tid) {
    const int ng = nrows >> 2, g = tid & (ng - 1), c = (nrows == 128) ? (tid >> 5) : (tid >> 4);
    if (c < 16) {
        LAS unsigned char* d = dst + (8 * c) * TP + g * 8;
#pragma unroll
        for (int w = 0; w < 4; ++w) {
            const unsigned a0 = r[0][w], a1 = r[1][w], a2 = r[2][w], a3 = r[3][w];
            u32x2 lo, hi;
            lo.x = (a0 & 0xffffu) | (a1 << 16); lo.y = (a2 & 0xffffu) | (a3 << 16);
            hi.x = (a0 >> 16) | (a1 & 0xffff0000u); hi.y = (a2 >> 16) | (a3 & 0xffff0000u);
            *(LAS u32x2*)(d + (2 * w) * TP) = lo; *(LAS u32x2*)(d + (2 * w + 1) * TP) = hi;
        }
    }
}
__device__ __forceinline__ void nat_issue(u32x4 (&r)[4], const bf16_t* src, size_t ld, int tid) {
#pragma unroll
    for (int q = 0; q < 4; ++q) { const int id = tid + 512 * q, row = id >> 4, c = id & 15; r[q] = *(const u32x4*)(src + (size_t)row * ld + c * 8); }
}
__device__ __forceinline__ void nat_commit(LAS unsigned char* dst, const u32x4 (&r)[4], int tid) {
#pragma unroll
    for (int q = 0; q < 4; ++q) { const int id = tid + 512 * q, row = id >> 4, c = id & 15; *(LAS u32x4*)(dst + row * TP + c * 16) = r[q]; }
}
__device__ __forceinline__ void store_acc_bf16(bf16_t* dst, size_t ld, const f32x4 (&acc)[2][4], int wr, int wc, int fr, int fq) {
#pragma unroll
    for (int mi = 0; mi < 2; ++mi)
#pragma unroll
        for (int ni = 0; ni < 4; ++ni) {
            u32x2 w; w.x = cvt_pk_bf16(acc[mi][ni][0], acc[mi][ni][1]); w.y = cvt_pk_bf16(acc[mi][ni][2], acc[mi][ni][3]);
            *(u32x2*)(dst + (size_t)(32 * wr + 16 * mi + fr) * ld + 64 * wc + 16 * ni + 4 * fq) = w;
        }
}
__device__ __forceinline__ void store_acc_lds(LAS unsigned char* dst, const f32x4 (&acc)[2][4], int wr, int wc, int fr, int fq) {
#pragma unroll
    for (int mi = 0; mi < 2; ++mi)
#pragma unroll
        for (int ni = 0; ni < 4; ++ni) {
            u32x2 w; w.x = cvt_pk_bf16(acc[mi][ni][0], acc[mi][ni][1]); w.y = cvt_pk_bf16(acc[mi][ni][2], acc[mi][ni][3]);
            *(LAS u32x2*)(dst + (32 * wr + 16 * mi + fr) * TP + (64 * wc + 16 * ni + 4 * fq) * 2) = w;
        }
}

__device__ __forceinline__ void phase_RA(const PRef& p, LAS unsigned char* lds, int l, int h) {
    int tid_ = threadIdx.x; asm volatile("" : "+v"(tid_)); const int tid = tid_, wid = tid >> 6, lane = tid & 63, wr = wid >> 1, wc = wid & 1, fr = lane & 15, fq = lane >> 4;
    unsigned char* hb = p.ws() + WS_HB + (size_t)h * HB_STRIDE; unsigned char* db = (unsigned char*)p.out() + (size_t)h * DO_STRIDE;
    const bf16_t* Kb = (const bf16_t*)(hb + HB_K);
    const bf16_t* Vb = (const bf16_t*)(hb + HB_V);
    bf16_t* KVF = (bf16_t*)(db + DO_KVF); bf16_t* KVB = (bf16_t*)(db + DO_KVB);
    LAS unsigned char* R0 = lds; LAS unsigned char* R1 = lds + TREG; LAS unsigned char* R2 = lds + 2 * TREG;
    u32x4 kvr[4], vvr[4];
    const int g4 = tid & 31, cc = tid >> 5;
    if (blockIdx.x < 1024) {
        const int u = blockIdx.x, c = u >> 2, hd = u & 3;
        tr_issue(kvr, Kb + (size_t)(c * 128) * 512 + hd * 128, 512, 128, tid); tr_issue(vvr, Vb + (size_t)(c * 128) * 512 + hd * 128, 512, 128, tid);
    }
    for (int u = blockIdx.x; u < 1024; u += gridDim.x) {
        const int hd = u & 3;
        const float lf2 = p.in(7)[l * 4 + hd] * LOG2E, lb2 = p.in(8)[l * 4 + hd] * LOG2E;
        tr_commit(R0, vvr, 128, tid);
        {
            float df[4], dbk[4];
#pragma unroll
            for (int q = 0; q < 4; ++q) { const int j = 4 * g4 + q; df[q] = __builtin_amdgcn_exp2f(lf2 * (float)(127 - j)); dbk[q] = __builtin_amdgcn_exp2f(lb2 * (float)(j + 1)); }
            const int o = (8 * cc) * TP + g4 * 8;
#pragma unroll
            for (int w = 0; w < 4; ++w) {
                const unsigned a0 = kvr[0][w], a1 = kvr[1][w], a2 = kvr[2][w], a3 = kvr[3][w];
                u32x2 t;
                t.x = cvt_pk_bf16(bflo(a0) * df[0], bflo(a1) * df[1]); t.y = cvt_pk_bf16(bflo(a2) * df[2], bflo(a3) * df[3]); *(LAS u32x2*)(R1 + o + (2 * w) * TP) = t;
                t.x = cvt_pk_bf16(bfhi(a0) * df[0], bfhi(a1) * df[1]); t.y = cvt_pk_bf16(bfhi(a2) * df[2], bfhi(a3) * df[3]); *(LAS u32x2*)(R1 + o + (2 * w + 1) * TP) = t;
                t.x = cvt_pk_bf16(bflo(a0) * dbk[0], bflo(a1) * dbk[1]); t.y = cvt_pk_bf16(bflo(a2) * dbk[2], bflo(a3) * dbk[3]); *(LAS u32x2*)(R2 + o + (2 * w) * TP) = t;
                t.x = cvt_pk_bf16(bfhi(a0) * dbk[0], bfhi(a1) * dbk[1]); t.y = cvt_pk_bf16(bfhi(a2) * dbk[2], bfhi(a3) * dbk[3]); *(LAS u32x2*)(R2 + o + (2 * w + 1) * TP) = t;
            }
        }
        __syncthreads();
        { const int un = u + gridDim.x; if (un < 1024) {
            const int c = un >> 2, hdn = un & 3;
            tr_issue(kvr, Kb + (size_t)(c * 128) * 512 + hdn * 128, 512, 128, tid); tr_issue(vvr, Vb + (size_t)(c * 128) * 512 + hdn * 128, 512, 128, tid);
        } }
        f32x4 acc[2][4];
        zero_acc(acc); mm_tile(acc, R0, R1, wr, wc, fr, fq, 4); store_acc_bf16(KVF + (size_t)u * 16384, 128, acc, wr, wc, fr, fq);
        zero_acc(acc); mm_tile(acc, R0, R2, wr, wc, fr, fq, 4); store_acc_bf16(KVB + (size_t)u * 16384, 128, acc, wr, wc, fr, fq);
        __syncthreads();
    }
}
__device__ __forceinline__ void phase_RB(const PRef& p, int l, int h) {
    const int nseq = h ? 4 : 2, ncs = h ? 64 : 128;
    const int ntasks = nseq * 65536;
    int tid_ = threadIdx.x; asm volatile("" : "+v"(tid_));
    for (int task = blockIdx.x * 512 + tid_; task < ntasks; task += gridDim.x * 512) {
        const int pp = task & 8191, dir = (task >> 13) & 1, hd = (task >> 14) & 3, seq = task >> 16;
        unsigned* base = (unsigned*)((unsigned char*)p.out() + (size_t)h * DO_STRIDE + (dir ? DO_KVB : DO_KVF)) + ((size_t)(seq * ncs) * 4 + hd) * 8192 + pp;
        const float ld = dir ? p.in(8)[l * 4 + hd] : p.in(7)[l * 4 + hd];
        const float dec = __builtin_amdgcn_exp2f(ld * LOG2E * 128.0f);
        float s0 = 0.f, s1 = 0.f;
        for (int c0 = 0; c0 < ncs; c0 += 32) {
            unsigned v[32];
#pragma unroll
            for (int i = 0; i < 32; ++i) { const int cc = dir ? (ncs - 1 - (c0 + i)) : (c0 + i); v[i] = base[(size_t)cc * 32768]; }
#pragma unroll
            for (int i = 0; i < 32; ++i) { const int cc = dir ? (ncs - 1 - (c0 + i)) : (c0 + i); base[(size_t)cc * 32768] = cvt_pk_bf16(s0, s1); s0 = s0 * dec + bflo(v[i]); s1 = s1 * dec + bfhi(v[i]); }
        }
    }
}
__device__ __forceinline__ void phase_RC(const PRef& p, LAS unsigned char* lds, int l, int h) {
    int tid_ = threadIdx.x; asm volatile("" : "+v"(tid_)); const int tid = tid_, wid = tid >> 6, lane = tid & 63, wr = wid >> 1, wc = wid & 1, fr = lane & 15, fq = lane >> 4;
    unsigned char* hb = p.ws() + WS_HB + (size_t)h * HB_STRIDE; unsigned char* db = (unsigned char*)p.out() + (size_t)h * DO_STRIDE;
    const bf16_t* Qb = (const bf16_t*)(hb + HB_Q);
    const bf16_t* Kb = (const bf16_t*)(hb + HB_K); const bf16_t* Vb = (const bf16_t*)(hb + HB_V); const bf16_t* SGb = (const bf16_t*)(hb + HB_SG);
    const bf16_t* KVF = (const bf16_t*)(db + DO_KVF); const bf16_t* KVB = (const bf16_t*)(db + DO_KVB);
    bf16_t* Rb = (bf16_t*)(hb + HB_Q);
    LAS unsigned char* R0 = lds; LAS unsigned char* R1 = lds + TREG; LAS unsigned char* R2 = lds + 2 * TREG; LAS unsigned char* R3 = lds + 3 * TREG;
    for (int u = blockIdx.x; u < 1024; u += gridDim.x) {
        const int c = u >> 2, hd = u & 3;
        const float lf2 = p.in(7)[l * 4 + hd] * LOG2E, lb2 = p.in(8)[l * 4 + hd] * LOG2E;
        const size_t toff = (size_t)(c * 128) * 512 + hd * 128;
        load_nat(R0, Qb + toff, 512, 128, tid); load_nat(R1, Kb + toff, 512, 128, tid); load_tr(R2, Vb + toff, 512, 128, tid); load_nat(R3, KVF + (size_t)u * 16384, 128, 128, tid);
        __syncthreads();
        f32x4 accS[2][4], accY[2][4];
        u32x4 sbr[4]; nat_issue(sbr, KVB + (size_t)u * 16384, 128, tid);
        zero_acc(accS); mm_tile(accS, R0, R1, wr, wc, fr, fq, 4);
        zero_acc(accY); mm_tile(accY, R0, R3, wr, wc, fr, fq, 4);
        __syncthreads();
#pragma unroll
        for (int mi = 0; mi < 2; ++mi) {
            const int i = 32 * wr + 16 * mi + fr;
            const float af = __builtin_amdgcn_exp2f(lf2 * (float)(i + 1));
#pragma unroll
            for (int ni = 0; ni < 4; ++ni) {
                const int j0 = 64 * wc + 16 * ni + 4 * fq;
                float pv[4];
#pragma unroll
                for (int jj = 0; jj < 4; ++jj) { const int d = i - (j0 + jj); const float w = (d >= 0) ? __builtin_amdgcn_exp2f(lf2 * (float)d) : __builtin_amdgcn_exp2f(lb2 * (float)(-d)); pv[jj] = accS[mi][ni][jj] * w; }
                u32x2 w2; w2.x = cvt_pk_bf16(pv[0], pv[1]); w2.y = cvt_pk_bf16(pv[2], pv[3]);
                *(LAS u32x2*)(R1 + i * TP + j0 * 2) = w2;
                accY[mi][ni] = accY[mi][ni] * af;
            }
        }
        __syncthreads();
        mm_tile(accY, R1, R2, wr, wc, fr, fq, 4);
        __syncthreads();
        nat_commit(R2, sbr, tid);
        __syncthreads();
        f32x4 acc3[2][4];
        zero_acc(acc3); mm_tile(acc3, R0, R2, wr, wc, fr, fq, 4);
        LAS f32x2v* st = (LAS f32x2v*)R3;
#pragma unroll
        for (int mi = 0; mi < 2; ++mi) {
            const int i = 32 * wr + 16 * mi + fr;
            const float ab = __builtin_amdgcn_exp2f(lb2 * (float)(127 - i));
            float s = 0.f, q = 0.f;
#pragma unroll
            for (int ni = 0; ni < 4; ++ni) {
                const f32x4 y = accY[mi][ni] + ab * acc3[mi][ni];
                accY[mi][ni] = y;
                s += (y[0] + y[1]) + (y[2] + y[3]); q += (y[0] * y[0] + y[1] * y[1]) + (y[2] * y[2] + y[3] * y[3]);
            }
            s += __shfl_xor(s, 16); s += __shfl_xor(s, 32); q += __shfl_xor(q, 16); q += __shfl_xor(q, 32);
            if (fq == 0) st[i * 2 + wc] = (f32x2v){s, q};
        }
        __syncthreads();
#pragma unroll
        for (int mi = 0; mi < 2; ++mi) {
            const int i = 32 * wr + 16 * mi + fr;
            const f32x2v a = st[i * 2 + 0], b = st[i * 2 + 1];
            const float mean = (a.x + b.x) * (1.0f / 128.0f), var = (a.y + b.y) * (1.0f / 128.0f) - mean * mean;
            const float rs = 1.0f / sqrtf(fmaxf(var, 0.f) + 1e-6f);
#pragma unroll
            for (int ni = 0; ni < 4; ++ni) {
                const size_t off = toff + (size_t)i * 512 + 64 * wc + 16 * ni + 4 * fq;
                const u32x2 sg = *(const u32x2*)(SGb + off);
                const f32x4 y = accY[mi][ni];
                u32x2 w2; w2.x = cvt_pk_bf16(bflo(sg.x) * (y[0] - mean) * rs, bfhi(sg.x) * (y[1] - mean) * rs); w2.y = cvt_pk_bf16(bflo(sg.y) * (y[2] - mean) * rs, bfhi(sg.y) * (y[3] - mean) * rs);
                *(u32x2*)(Rb + off) = w2;
            }
        }
        __syncthreads();
    }
}

__device__ __forceinline__ void fill_dft(LAS unsigned char* R0, LAS unsigned char* R1, int N, int tid) {
    const int sh = (N == 128) ? 7 : 6;
    const float invN = 1.0f / (float)N;
    for (int idx = tid; idx < N * N; idx += 512) {
        const int k = idx >> sh, n = idx & (N - 1);
        const float a = (float)((k * n) & (N - 1)) * invN;
        const unsigned pk = cvt_pk_bf16(__builtin_amdgcn_cosf(a), __builtin_amdgcn_sinf(a));
        *(LAS unsigned short*)(R0 + k * TP + n * 2) = (unsigned short)(pk & 0xffffu);
        *(LAS unsigned short*)(R1 + k * TP + n * 2) = (unsigned short)(pk >> 16);
    }
}
__device__ __forceinline__ void phase_FA(const PRef& p, LAS unsigned char* lds, int h) {
    int tid_ = threadIdx.x; asm volatile("" : "+v"(tid_)); const int tid = tid_, wid = tid >> 6, lane = tid & 63, wr = wid >> 1, wc = wid & 1, fr = lane & 15, fq = lane >> 4;
    const int N1 = h ? 64 : 128, nseq = h ? 4 : 2, S = N1 * 128, nunits = nseq * 512, ksteps = N1 / 32;
    const float invS = 1.0f / (float)S;
    const bf16_t* Fb = (const bf16_t*)(p.ws() + WS_HB + (size_t)h * HB_STRIDE + HB_F);
    unsigned char* db = (unsigned char*)p.out() + (size_t)h * DO_STRIDE;
    bf16_t* APR = (bf16_t*)(db + DO_APR); bf16_t* API = (bf16_t*)(db + DO_API);
    LAS unsigned char* R0 = lds; LAS unsigned char* R1 = lds + TREG; LAS unsigned char* R2 = lds + 2 * TREG;
    fill_dft(R0, R1, N1, tid);
    __syncthreads();
    u32x4 pf[4];
    if ((int)blockIdx.x < nunits) { const int u = blockIdx.x, g = u & 3, n2 = (u >> 2) & 127, seq = u >> 9; tr_issue(pf, Fb + ((size_t)seq * S + n2) * 512 + g * 128, (size_t)128 * 512, N1, tid); }
    for (int u = blockIdx.x; u < nunits; u += gridDim.x) {
        const int g = u & 3, n2 = (u >> 2) & 127, seq = u >> 9;
        tr_commit(R2, pf, N1, tid);
        __syncthreads();
        { const int un = u + gridDim.x; if (un < nunits) { const int gn = un & 3, n2n = (un >> 2) & 127, seqn = un >> 9; tr_issue(pf, Fb + ((size_t)seqn * S + n2n) * 512 + gn * 128, (size_t)128 * 512, N1, tid); } }
        if (64 * wr <= N1) {
            f32x4 P1[2][4], P2[2][4];
            zero_acc(P1); mm_tile(P1, R0, R2, wr, wc, fr, fq, ksteps);
            zero_acc(P2); mm_tile(P2, R1, R2, wr, wc, fr, fq, ksteps);
#pragma unroll
            for (int mi = 0; mi < 2; ++mi) {
                const int k1 = 32 * wr + 16 * mi + fr;
                const float a = (float)(n2 * k1) * invS, cs = __builtin_amdgcn_cosf(a), sn = __builtin_amdgcn_sinf(a);
                const size_t rowoff = ((size_t)seq * S + (size_t)k1 * 128 + n2) * 512 + g * 128 + 64 * wc + 4 * fq;
                if (2 * k1 <= N1) {
#pragma unroll
                for (int ni = 0; ni < 4; ++ni) {
                    const f32x4 re = P1[mi][ni] * cs - P2[mi][ni] * sn, im = -(P2[mi][ni] * cs + P1[mi][ni] * sn);
                    u32x2 w; w.x = cvt_pk_bf16(re[0], re[1]); w.y = cvt_pk_bf16(re[2], re[3]); *(u32x2*)(APR + rowoff + 16 * ni) = w;
                    w.x = cvt_pk_bf16(im[0], im[1]); w.y = cvt_pk_bf16(im[2], im[3]); *(u32x2*)(API + rowoff + 16 * ni) = w;
                }
                }
            }
        }
        __syncthreads();
    }
}
__device__ __forceinline__ void phase_FB(const PRef& p, LAS unsigned char* lds, int h) {
    int tid_ = threadIdx.x; asm volatile("" : "+v"(tid_)); const int tid = tid_, wid = tid >> 6, lane = tid & 63, wr = wid >> 1, wc = wid & 1, fr = lane & 15, fq = lane >> 4;
    const int N1 = h ? 64 : 128, nseq = h ? 4 : 2, S = N1 * 128, nk = N1 / 2 - 1, ND = nseq * nk * 4, NSLOT = ND + nseq * 4;
    const float scale = h ? 0.0009765625f : 0.0006905339660024878f;
    unsigned char* db = (unsigned char*)p.out() + (size_t)h * DO_STRIDE;
    const bf16_t* APR = (const bf16_t*)(db + DO_APR); const bf16_t* API = (const bf16_t*)(db + DO_API);
    bf16_t* FR = (bf16_t*)(p.ws() + WS_HB + (size_t)h * HB_STRIDE + HB_F);
    LAS unsigned char* R0 = lds; LAS unsigned char* R1 = lds + TREG; LAS unsigned char* R2 = lds + 2 * TREG; LAS unsigned char* R3 = lds + 3 * TREG;
    fill_dft(R0, R1, 128, tid);
    __syncthreads();
    for (int sl = blockIdx.x; sl < NSLOT; sl += gridDim.x) {
        const int nit = (sl < ND) ? 1 : 2;
#pragma unroll 1
        for (int e = 0; e < nit; ++e) {
            int g, k1, seq; bool mirror;
            if (sl < ND) { g = sl & 3; const int t = sl >> 2; seq = t / nk; k1 = t - seq * nk + 1; mirror = true; }
            else { const int sidx = 2 * (sl - ND) + e; g = sidx & 3; k1 = ((sidx >> 2) & 1) ? N1 / 2 : 0; seq = sidx >> 3; mirror = false; }
            const size_t soff = ((size_t)seq * S + (size_t)k1 * 128) * 512 + g * 128;
            load_tr(R2, APR + soff, 512, 128, tid); load_tr(R3, API + soff, 512, 128, tid);
            __syncthreads();
            f32x4 aR[2][4], a3[2][4], a4[2][4];
            zero_acc(aR); mm_tile(aR, R0, R2, wr, wc, fr, fq, 4); mm_tile(aR, R1, R3, wr, wc, fr, fq, 4);
            zero_acc(a3); mm_tile(a3, R0, R3, wr, wc, fr, fq, 4);
            zero_acc(a4); mm_tile(a4, R1, R2, wr, wc, fr, fq, 4);
            __syncthreads();
#pragma unroll
            for (int mi = 0; mi < 2; ++mi)
#pragma unroll
                for (int ni = 0; ni < 4; ++ni) a3[mi][ni] = a3[mi][ni] - a4[mi][ni];
            store_acc_lds(R2, aR, wr, wc, fr, fq); store_acc_lds(R3, a3, wr, wc, fr, fq);
            __syncthreads();
            zero_acc(aR); mm_tile(aR, R2, R0, wr, wc, fr, fq, 4);
            zero_acc(a3); mm_tile(a3, R3, R1, wr, wc, fr, fq, 4);
#pragma unroll
            for (int mi = 0; mi < 2; ++mi) {
                const int k2 = 32 * wr + 16 * mi + fr;
                const size_t coloff = (size_t)g * 128 + 64 * wc + 4 * fq;
                const size_t row = (size_t)seq * S + k1 + (size_t)N1 * k2, mrow = (size_t)seq * S + (N1 - k1) + (size_t)N1 * (127 - k2);
#pragma unroll
                for (int ni = 0; ni < 4; ++ni) {
                    const f32x4 o = (aR[mi][ni] + a3[mi][ni]) * scale;
                    u32x2 w; w.x = cvt_pk_bf16(o[0], o[1]); w.y = cvt_pk_bf16(o[2], o[3]); *(u32x2*)(FR + row * 512 + coloff + 16 * ni) = w;
                    if (mirror) {
                        const f32x4 om = (aR[mi][ni] - a3[mi][ni]) * scale;
                        u32x2 wm; wm.x = cvt_pk_bf16(om[0], om[1]); wm.y = cvt_pk_bf16(om[2], om[3]); *(u32x2*)(FR + mrow * 512 + coloff + 16 * ni) = wm;
                    }
                }
            }
            __syncthreads();
        }
    }
}

struct Ctx { unsigned char* ws; unsigned char* dout; bf16_t* XB; float* RS; float* SS; const bf16_t* Wl; };
__device__ __forceinline__ void st_ffn_in(const Ctx& c, LAS unsigned char* lds, int hh, int second) {
    EpiSwiGLU E; E.U = hh ? (bf16_t*)(c.dout + DO_U1) : (bf16_t*)(c.ws + WS_U0); E.rs = c.RS + hh * HT;
    run_gemm(lds, c.XB + (size_t)hh * HT * 1024, c.Wl + (second ? WO_F2I : WO_F1I), HT, 5632, 1024, E);
}
__device__ __forceinline__ void st_ffn_out(const Ctx& c, LAS unsigned char* lds, int hh, int second) {
    EpiRes E; E.X = c.XB + (size_t)hh * HT * 1024; E.ss = c.SS + (size_t)hh * HT * 16; E.scale = 0.5f;
    run_gemm(lds, hh ? (const bf16_t*)(c.dout + DO_U1) : (const bf16_t*)(c.ws + WS_U0), c.Wl + (second ? WO_F2O : WO_F1O), HT, 1024, 2816, E);
}
__device__ __forceinline__ void st_rowstat(const Ctx& c, int hh) { rowstat_slots(c.SS + (size_t)hh * HT * 16, c.RS + hh * HT, HT); }
__device__ __forceinline__ void st_win(const Ctx& c, LAS unsigned char* lds, int hh) {
    EpiWin E; E.base = (bf16_t*)(c.ws + WS_HB + (size_t)hh * HB_STRIDE); E.rope = (const float*)(c.ws + WS_ROPE); E.rs = c.RS + hh * HT; E.smask = hh ? 8191 : 16383;
    run_gemm(lds, c.XB + (size_t)hh * HT * 1024, c.Wl + WO_WIN, HT, 2560, 1024, E);
}
__device__ __forceinline__ void st_retfou(const Ctx& c, LAS unsigned char* lds, int hh) {
    unsigned char* hb = c.ws + WS_HB + (size_t)hh * HB_STRIDE; unsigned char* db = c.dout + (size_t)hh * DO_STRIDE;
#pragma unroll 1
    for (int t = 0; t < 2; ++t) {
        EpiBf E; E.O = t ? (bf16_t*)(db + DO_FOU) : (bf16_t*)(hb + HB_RET);
        run_gemm<EpiBf, BF_ALIGN>(lds, (const bf16_t*)(hb + (t ? HB_F : HB_Q)), c.Wl + (t ? WO_FFT : WO_RET), HT, 1024, 512, E);
    }
}
__device__ __forceinline__ void st_gates(const Ctx& c, LAS unsigned char* lds, int hh) {
    unsigned char* hb = c.ws + WS_HB + (size_t)hh * HB_STRIDE; unsigned char* db = c.dout + (size_t)hh * DO_STRIDE;
    EpiGates E; E.RET = (const bf16_t*)(hb + HB_RET); E.FOU = (const bf16_t*)(db + DO_FOU); E.MRG = (bf16_t*)(db + DO_MRG); E.rs = c.RS + hh * HT;
    run_gemm(lds, c.XB + (size_t)hh * HT * 1024, c.Wl + WO_WIN + 2560ull * 1024, HT, 2048, 1024, E);
}
__device__ __forceinline__ void st_mix(const Ctx& c, LAS unsigned char* lds, int hh) {
    EpiRes E; E.X = c.XB + (size_t)hh * HT * 1024; E.ss = c.SS + (size_t)hh * HT * 16; E.scale = 1.0f;
    run_gemm(lds, (const bf16_t*)(c.dout + (size_t)hh * DO_STRIDE + DO_MRG), c.Wl + WO_MIX, HT, 1024, 1024, E);
}
__device__ __forceinline__ void run_phase(const PRef& p, LAS unsigned char* lds, int ph) {
    Ctx c; c.ws = p.ws(); c.dout = (unsigned char*)p.out(); c.XB = (bf16_t*)(c.ws + WS_XB); c.RS = (float*)(c.ws + WS_RS); c.SS = (float*)(c.ws + WS_SS); c.Wl = (const bf16_t*)(c.ws + WS_W);
    if (ph == 0) {
        phase_prep(p, lds, 0, 7);
        rows_init(p.in(0), c.XB, c.RS, HT); rows_init(p.in(1), c.XB + (size_t)HT * 1024, c.RS + HT, HT);
        return;
    }
    if (ph == NPHASES - 1) { final_norm(c.XB, p.in(15), p.out(), 2 * HT); return; }
    const int q = ph - 1, l = q / 14, s = q % 14;
    switch (s) {
    case 0:  st_ffn_in(c, lds, 0, 0); if (l > 0) st_rowstat(c, 1); break;
    case 1:  st_ffn_out(c, lds, 0, 0); st_ffn_in(c, lds, 1, 0); break;
    case 2:  st_ffn_out(c, lds, 1, 0); st_rowstat(c, 0); if (l > 0) phase_prep(p, lds, l, 2); break;
    case 3:  st_win(c, lds, 0); st_rowstat(c, 1); break;
    case 4:  st_win(c, lds, 1); phase_RA(p, lds, l, 0); phase_FA(p, lds, 0); break;
    case 5:  phase_RA(p, lds, l, 1); phase_FA(p, lds, 1); phase_RB(p, l, 0); phase_FB(p, lds, 0); break;
    case 6:  phase_RC(p, lds, l, 0); phase_RB(p, l, 1); phase_FB(p, lds, 1); break;
    case 7:  st_retfou(c, lds, 0); phase_RC(p, lds, l, 1); break;
    case 8:  st_gates(c, lds, 0); st_retfou(c, lds, 1); break;
    case 9:  st_mix(c, lds, 0); st_gates(c, lds, 1); break;
    case 10: st_mix(c, lds, 1); st_rowstat(c, 0); break;
    case 11: st_ffn_in(c, lds, 0, 1); st_rowstat(c, 1); if (l == 0) phase_prep(p, lds, l + 1, 1); break;
    case 12: st_ffn_out(c, lds, 0, 1); st_ffn_in(c, lds, 1, 1); break;
    default: st_ffn_out(c, lds, 1, 1); if (l == 0) st_rowstat(c, 0); break;
    }
}

__global__ void __launch_bounds__(512, 2) fwd_megakernel(Params p0) {
    extern __shared__ __attribute__((aligned(16))) unsigned char shm[];
    LAS unsigned char* lds = (LAS unsigned char*)shm;
    volatile LAS unsigned* st = (volatile LAS unsigned*)(lds + LDS_TILES);
    if (threadIdx.x == 0) { st[0] = 0u; st[1] = 0u; }
    __syncthreads();
    (void)xcd_barrier_post((unsigned*)(p0.ws + WS_CTL), st);
    const int ph_lo = p0.ph_lo, ph_hi = p0.ph_hi;
    for (int ph = ph_lo; ph < ph_hi; ++ph) {
        PRef p; p.kp = (const AS4 Params*)__builtin_amdgcn_kernarg_segment_ptr();
        asm volatile("" : "+s"(p.kp));
        run_phase(p, lds, ph);
        if (ph + 1 < ph_hi) {
            if (ph == ph_lo) { __threadfence(); cg::this_grid().sync(); }
            else { XcdBarrier xb; xb.bar = (unsigned*)(p.ws() + WS_CTL); xb.x = xb_xcc_id(); xb.st = (volatile LAS unsigned*)(lds + LDS_TILES); xcd_barrier(xb);
#ifdef DBLBAR
                xcd_barrier(xb);
#endif
            }
        }
    }
}

extern "C" void kernel_launch(void* const* d_in, const int* in_sizes, int n_in, void* d_out, int out_size, void* d_ws, size_t ws_size, hipStream_t stream) {
    static int grid = 0;
    if (grid == 0) {
        if (n_in != 16 || out_size != 2 * HT * 1024 || ws_size < WS_END) { fprintf(stderr, "kernel_launch: unexpected shapes (n_in %d out %d ws %zu)\n", n_in, out_size, ws_size); grid = -1; return; }
        int dev = 0, cus = 0, per_cu = 0;
        if (hipGetDevice(&dev) != hipSuccess || hipDeviceGetAttribute(&cus, hipDeviceAttributeMultiprocessorCount, dev) != hipSuccess) { grid = -1; return; }
        if (hipFuncSetAttribute((const void*)fwd_megakernel, hipFuncAttributeMaxDynamicSharedMemorySize, LDS_BYTES) != hipSuccess) { fprintf(stderr, "kernel_launch: hipFuncSetAttribute failed\n"); grid = -1; return; }
        if (hipOccupancyMaxActiveBlocksPerMultiprocessor(&per_cu, (const void*)fwd_megakernel, 512, LDS_BYTES) != hipSuccess || per_cu < 1) { fprintf(stderr, "kernel_launch: occupancy query says %d\n", per_cu); per_cu = 1; }
        (void)hipGetLastError();
        grid = cus;
    }
    if (grid < 0) return;
    if (hipMemsetAsync((unsigned char*)d_ws + WS_CTL, 0, XCD_BAR_WORDS * sizeof(unsigned), stream) != hipSuccess) return;
    Params p{};
    for (int i = 0; i < 16; ++i) p.in[i] = (const float*)d_in[i];
    p.out = (float*)d_out; p.ws = (unsigned char*)d_ws;
#if MK_ONE_LAUNCH
    p.ph_lo = 0; p.ph_hi = NPHASES;
    void* args[] = {&p};
    hipError_t e = hipLaunchCooperativeKernel((const void*)fwd_megakernel, dim3(grid), dim3(512), args, LDS_BYTES, stream);
    if (e != hipSuccess) fprintf(stderr, "cooperative launch failed: %s (grid %d)\n", hipGetErrorString(e), grid);
#else
    for (int ph = 0; ph < NPHASES; ++ph) {
        p.ph_lo = ph; p.ph_hi = ph + 1;
        hipLaunchKernelGGL(fwd_megakernel, dim3(grid), dim3(512), LDS_BYTES, stream, p);
    }
#endif
}
```

```cpp
#include <hip/hip_runtime.h>
#include <hip/hip_cooperative_groups.h>
#include <cstdio>
#include <cstdint>
namespace cg = cooperative_groups;
#ifndef MK_ONE_LAUNCH
#define MK_ONE_LAUNCH 1
#endif
#define SKIP_FFT 0
#define OUT_SCALE 1.0f
#ifndef GEMM_ALIGN
#define GEMM_ALIGN true
#endif
#ifndef GEMM_SP2
#define GEMM_SP2 true
#endif
#ifndef RES_ALIGN
#define RES_ALIGN true
#endif
#ifndef SWI_ALIGN
#define SWI_ALIGN true
#endif
#ifndef WGM_SET
#define WGM_SET 4
#endif
namespace pg8 {
#define PG8_LAS __attribute__((address_space(3)))
typedef unsigned short bf16_t;
typedef short bf16x8 __attribute__((ext_vector_type(8)));
typedef float f32x4 __attribute__((ext_vector_type(4)));
typedef unsigned u32x4 __attribute__((ext_vector_type(4)));
constexpr int BM = 256, BK = 64, HALF = 128, HTB = HALF * BK * 2  , STAGE_BYTES = 8 * HTB, NXCD = 8, WGM = WGM_SET;

__host__ __device__ __forceinline__ int lds_byte(int r, int c) { const int st = (r >> 4) * 2 + (c >> 5), rr = r & 15, cc = c & 31, ob = rr * 64 + cc * 2; return st * 1024 + (ob ^ (((ob >> 9) & 1) << 5)); }
__host__ __device__ __forceinline__ void stage_rc(int b, int& R, int& C) { const int st = b / 1024, sb = b % 1024, swz = sb ^ (((sb >> 9) & 1) << 5); R = (st >> 1) * 16 + swz / 64; C = (st & 1) * 32 + (swz % 64) / 2; }
__host__ __device__ __forceinline__ int perm32(int rho) { const int n = rho >> 4, i = rho & 15; return 8 * (i >> 2) + 4 * n + (i & 3); }

struct Unit { int pm, pn; };
struct Gemm { const bf16_t* A; const bf16_t* Bt; int M, N, K; };

struct StaticOrder {
    int nM, nN, nwg, G, c;
    __host__ __device__ void init(int M, int N, int G_, int c_) { nM = M / BM; nN = N / BM; nwg = nM * nN; G = G_; c = c_; }
    __host__ __device__ bool next(int i, Unit& u) const {
        const long L = (long)i * G + c; if (L >= nwg) return false;
        int wgid = (int)L; { const int q = nwg / NXCD, r = nwg % NXCD, xcd = wgid % NXCD, off = wgid / NXCD; wgid = (xcd < r ? xcd * (q + 1) : r * (q + 1) + (xcd - r) * q) + off; }
        const int nig = WGM * nN, gid = wgid / nig, fm = gid * WGM, gsz = (nM - fm) < WGM ? (nM - fm) : WGM;
        u.pm = fm + ((wgid % nig) % gsz); u.pn = (wgid % nig) / gsz; return true;
    }
    __device__ __forceinline__ void a_ready(const Unit&) const {}
    __device__ __forceinline__ void done(const Unit&) const {}
};
typedef __bf16 bf16v2_t __attribute__((ext_vector_type(2)));
typedef float f32v2_t __attribute__((ext_vector_type(2)));
__device__ __forceinline__ unsigned cvt_pk_bf16(float lo, float hi) { const f32v2_t v = {lo, hi}; const bf16v2_t r = __builtin_convertvector(v, bf16v2_t); return __builtin_bit_cast(unsigned, r); }
template <class Epi, class Sched, bool ALIGN_EPI = false, bool SP2 = false>
__device__ __forceinline__ void gemm_phase(PG8_LAS unsigned char* lds, const Gemm g, const Sched& S, const Epi& E) {
    int tid_ = threadIdx.x; asm volatile("" : "+v"(tid_)); const int tid = tid_, wid = __builtin_amdgcn_readfirstlane(tid >> 6), lane = tid & 63, wr = wid >> 2, wc = wid & 3, fr = lane & 15, fq = lane >> 4;
    const int K = g.K, nt = K / BK;
    unsigned voffA[2], voffB[2];
#pragma unroll
    for (int i = 0; i < 2; ++i) { int R, C; stage_rc(tid * 16 + i * 8192, R, C); const int Rb = Epi::PERM ? ((R & ~31) + perm32(R & 31)) : R;
        voffA[i] = (unsigned)(R * K + C) * 2u; voffB[i] = (unsigned)(Rb * K + C) * 2u; }
    const size_t kstep = (size_t)(BK * 2);
    const size_t hstep = (size_t)HALF * K * 2;
    const size_t tstep = 2 * hstep;
    const unsigned ldsw = (unsigned)wid * 1024u;
    const int aoff = lds_byte(wr * 64 + fr, fq * 8), boff = lds_byte(wc * 32 + fr, fq * 8);
#define PG8_SA(b, h) (((b) * 2 + (h)) * HTB)
#define PG8_SB(b, h) ((4 + (b) * 2 + (h)) * HTB)
#define PG8_STAGE(bufoff, gbase, voff) do { _Pragma("unroll") for (int _i = 0; _i < 2; ++_i) \
        __builtin_amdgcn_global_load_lds((const unsigned*)((const char*)(gbase) + (voff)[_i]), (PG8_LAS unsigned*)(lds + (bufoff) + ldsw + _i * 8192), 16, 0, 0); } while (0)
#define PG8_LDA(dst, b, h) do { _Pragma("unroll") for (int m = 0; m < 4; ++m) _Pragma("unroll") for (int k = 0; k < 2; ++k) dst[m][k] = *(const PG8_LAS bf16x8*)(lds + PG8_SA(b, h) + aoff + m * 2048 + k * 1024); } while (0)
#define PG8_LDB(dst, b, h) do { _Pragma("unroll") for (int n = 0; n < 2; ++n) _Pragma("unroll") for (int k = 0; k < 2; ++k) dst[n][k] = *(const PG8_LAS bf16x8*)(lds + PG8_SB(b, h) + boff + n * 2048 + k * 1024); } while (0)
#define PG8_MMA(ai, bj, At, Bt) do { __builtin_amdgcn_s_setprio(1); _Pragma("unroll") for (int m = 0; m < 4; ++m) _Pragma("unroll") for (int n = 0; n < 2; ++n) _Pragma("unroll") for (int k = 0; k < 2; ++k) \
        acc[ai][bj][m][n] = __builtin_amdgcn_mfma_f32_16x16x32_bf16(Bt[n][k], At[m][k], acc[ai][bj][m][n], 0, 0, 0); __builtin_amdgcn_s_setprio(0); } while (0)
#define PG8_WAIT_V(n) asm volatile("s_waitcnt vmcnt(" #n ")" ::: "memory")
#define PG8_WAIT_L(n) asm volatile("s_waitcnt lgkmcnt(" #n ")" ::: "memory")
#define PG8_BAR __builtin_amdgcn_s_barrier()
#define PG8_SCHED __builtin_amdgcn_sched_barrier(0)
    Unit cur, nxt; int ui = 0;
    if (!S.next(0, cur)) return;
    f32x4 acc[2][2][4][2];
#pragma unroll
    for (int a = 0; a < 2; ++a)
#pragma unroll
        for (int b = 0; b < 2; ++b)
#pragma unroll
            for (int m = 0; m < 4; ++m)
#pragma unroll
                for (int n = 0; n < 2; ++n) acc[a][b][m][n] = (f32x4){0.f, 0.f, 0.f, 0.f};
    bf16x8 At[4][2], B0[2][2], B1[2][2];
    const char* cA = (const char*)g.A + (size_t)cur.pm * tstep; const char* cB = (const char*)g.Bt + (size_t)cur.pn * tstep;
    S.a_ready(cur);
    if constexpr (SP2) {
        PG8_STAGE(PG8_SB(0, 0), cB, voffB); PG8_STAGE(PG8_SB(0, 1), cB + hstep, voffB); PG8_STAGE(PG8_SA(0, 0), cA, voffA); PG8_STAGE(PG8_SA(0, 1), cA + hstep, voffA);
        if (wr == 1) PG8_BAR;
        PG8_WAIT_V(2); PG8_BAR;
        PG8_STAGE(PG8_SB(1, 0), cB + kstep, voffB); PG8_STAGE(PG8_SA(1, 0), cA + kstep, voffA); PG8_STAGE(PG8_SB(1, 1), cB + hstep + kstep, voffB);
        PG8_WAIT_V(6); PG8_BAR;
    } else {
        PG8_STAGE(PG8_SB(0, 0), cB, voffB); PG8_STAGE(PG8_SA(0, 0), cA, voffA); PG8_STAGE(PG8_SB(0, 1), cB + hstep, voffB); PG8_STAGE(PG8_SA(0, 1), cA + hstep, voffA);
        if (wr == 1) PG8_BAR;
        PG8_WAIT_V(4); PG8_BAR;
        PG8_STAGE(PG8_SB(1, 0), cB + kstep, voffB); PG8_STAGE(PG8_SA(1, 0), cA + kstep, voffA); PG8_STAGE(PG8_SB(1, 1), cB + hstep + kstep, voffB);
        PG8_WAIT_V(6); PG8_BAR;
    }
    for (;;) {
        const bool has_next = S.next(ui + 1, nxt);
        const char* nA = has_next ? (const char*)g.A + (size_t)nxt.pm * tstep : cA; const char* nB = has_next ? (const char*)g.Bt + (size_t)nxt.pn * tstep : cB;
        for (int t = 0; t < nt; t += 2) {
            const bool last = (t == nt - 2);
            const char* a1 = cA + (size_t)(t + 1) * kstep;
            const char* a2 = last ? nA : cA + (size_t)(t + 2) * kstep; const char* b2 = last ? nB : cB + (size_t)(t + 2) * kstep;
            const char* a3 = a2 + kstep; const char* b3 = b2 + kstep;
            if (last && has_next) S.a_ready(nxt);
            if constexpr (SP2) {
            PG8_LDB(B0, 0, 0); PG8_LDB(B1, 0, 1); PG8_SCHED; PG8_LDA(At, 0, 0); PG8_STAGE(PG8_SA(1, 1), a1 + hstep, voffA);
            PG8_WAIT_V(8); PG8_WAIT_L(0); PG8_BAR; PG8_MMA(0, 0, At, B0); PG8_MMA(0, 1, At, B1); PG8_BAR; PG8_SCHED;
            PG8_LDA(At, 0, 1); PG8_STAGE(PG8_SB(0, 0), b2, voffB); PG8_STAGE(PG8_SB(0, 1), b2 + hstep, voffB); PG8_STAGE(PG8_SA(0, 0), a2, voffA);
            PG8_WAIT_V(8); PG8_WAIT_L(0); PG8_BAR; PG8_MMA(1, 0, At, B0); PG8_MMA(1, 1, At, B1); PG8_BAR; PG8_SCHED;
            PG8_LDB(B0, 1, 0); PG8_LDB(B1, 1, 1); PG8_SCHED; PG8_LDA(At, 1, 0); PG8_STAGE(PG8_SA(0, 1), a2 + hstep, voffA);
            PG8_WAIT_V(8); PG8_WAIT_L(0); PG8_BAR; PG8_MMA(0, 0, At, B0); PG8_MMA(0, 1, At, B1); PG8_BAR; PG8_SCHED;
            PG8_LDA(At, 1, 1); PG8_STAGE(PG8_SB(1, 0), b3, voffB); PG8_STAGE(PG8_SB(1, 1), b3 + hstep, voffB); PG8_STAGE(PG8_SA(1, 0), a3, voffA);
            PG8_WAIT_V(8); PG8_WAIT_L(0); PG8_BAR; PG8_MMA(1, 0, At, B0); PG8_MMA(1, 1, At, B1); PG8_BAR; PG8_SCHED;
            } else {
            PG8_LDB(B0, 0, 0); PG8_SCHED; PG8_LDA(At, 0, 0); PG8_STAGE(PG8_SA(1, 1), a1 + hstep, voffA);
            PG8_WAIT_L(8); PG8_BAR; PG8_WAIT_L(0); PG8_MMA(0, 0, At, B0); PG8_BAR; PG8_SCHED;
            PG8_LDB(B1, 0, 1); PG8_STAGE(PG8_SB(0, 0), b2, voffB);
            PG8_BAR; PG8_WAIT_L(0); PG8_MMA(0, 1, At, B1); PG8_BAR;
            PG8_LDA(At, 0, 1); PG8_STAGE(PG8_SA(0, 0), a2, voffA);
            PG8_BAR; PG8_WAIT_L(0); PG8_MMA(1, 0, At, B0); PG8_BAR; PG8_SCHED;
            PG8_STAGE(PG8_SB(0, 1), b2 + hstep, voffB);
            PG8_WAIT_V(6); PG8_BAR; PG8_MMA(1, 1, At, B1); PG8_BAR;
            PG8_LDB(B0, 1, 0); PG8_SCHED; PG8_LDA(At, 1, 0); PG8_STAGE(PG8_SA(0, 1), a2 + hstep, voffA);
            PG8_WAIT_L(8); PG8_BAR; PG8_WAIT_L(0); PG8_MMA(0, 0, At, B0); PG8_BAR; PG8_SCHED;
            PG8_LDB(B1, 1, 1); PG8_STAGE(PG8_SB(1, 0), b3, voffB);
            PG8_BAR; PG8_WAIT_L(0); PG8_MMA(0, 1, At, B1); PG8_BAR;
            PG8_LDA(At, 1, 1); PG8_STAGE(PG8_SA(1, 0), a3, voffA);
            PG8_BAR; PG8_WAIT_L(0); PG8_MMA(1, 0, At, B0); PG8_BAR; PG8_SCHED;
            PG8_STAGE(PG8_SB(1, 1), b3 + hstep, voffB);
            PG8_WAIT_V(6); PG8_BAR; PG8_MMA(1, 1, At, B1); PG8_BAR;
            }
        }
        if constexpr (ALIGN_EPI) { if (wr == 0) PG8_BAR; }
        if constexpr (!Epi::AFTER_DRAIN) { E(acc, cur, wr, wc, fr, fq); S.done(cur); }
        if (!has_next) break;
#pragma unroll
        for (int a = 0; a < 2; ++a)
#pragma unroll
            for (int b = 0; b < 2; ++b)
#pragma unroll
                for (int m = 0; m < 4; ++m)
#pragma unroll
                    for (int n = 0; n < 2; ++n) acc[a][b][m][n] = (f32x4){0.f, 0.f, 0.f, 0.f};
        cur = nxt; cA = nA; cB = nB; ++ui;
        if constexpr (ALIGN_EPI) { if (wr == 1) PG8_BAR; }
    }
    PG8_WAIT_V(0);
    if constexpr (!ALIGN_EPI) { if (wr == 0) PG8_BAR; }
    PG8_BAR;
    if constexpr (Epi::AFTER_DRAIN) { E.fused(acc, cur, wr, wc, fr, fq, lds, wid, lane); S.done(cur); }
#undef PG8_SA
#undef PG8_SB
#undef PG8_STAGE
#undef PG8_LDA
#undef PG8_LDB
#undef PG8_MMA
#undef PG8_WAIT_V
#undef PG8_WAIT_L
#undef PG8_BAR
#undef PG8_SCHED
}
}
#define XB_TMO      128
#define XB_XCNT(j)  (256  + 64 * (j))
#define XB_XSUB(j)  (1280 + 64 * (j))
#define XB_XGEN(j)  (2304 + 64 * (j))
#define XB_TOP      3328
#define XB_TOPGEN   3392
#define XCD_BAR_WORDS 3456
#define XB_SPIN_CAP (1u << 18)
#define LAS __attribute__((address_space(3)))

__device__ __forceinline__ unsigned xb_ld(unsigned* p)              { return __hip_atomic_load(p, __ATOMIC_RELAXED, __HIP_MEMORY_SCOPE_AGENT); }
__device__ __forceinline__ unsigned xb_add(unsigned* p, unsigned v) { return __hip_atomic_fetch_add(p, v, __ATOMIC_RELAXED, __HIP_MEMORY_SCOPE_AGENT); }
__device__ __forceinline__ unsigned xb_xcc_id() { return (unsigned)__builtin_amdgcn_s_getreg((3 << 11) | 20) & 0xFu; }
#define XB_SPIN(cond, bar) do { unsigned _sp = 0; while (cond) { __builtin_amdgcn_s_sleep(1); \
    if ((++_sp & 255u) == 0u) { if (xb_ld(&(bar)[XB_TMO])) break; if (_sp > XB_SPIN_CAP) { atomicAdd(&(bar)[XB_TMO], 1u); break; } } } } while (0)

struct XcdBarrier {
    unsigned* bar; unsigned x;
    volatile LAS unsigned* st;
};

__device__ __forceinline__ XcdBarrier xcd_barrier_post(unsigned* bar, volatile LAS unsigned* st) {
    XcdBarrier b; b.bar = bar; b.x = xb_xcc_id(); b.st = st;
    if (threadIdx.x == 0) (void)xb_add(&bar[XB_XCNT(b.x)], 1u);
    return b;
}
__device__ __forceinline__ void xcd_barrier_complete(unsigned* bar, unsigned x, unsigned& nloc, unsigned& nx) {
    const unsigned G = gridDim.x * gridDim.y * gridDim.z;
    unsigned sum, cnt, mine, sp = 0u;
    for (;;) {
        sum = 0u; cnt = 0u; mine = 0u;
#pragma unroll
        for (unsigned j = 0; j < 16; ++j) { const unsigned c = xb_ld(&bar[XB_XCNT(j)]); sum += c; cnt += (c > 0u) ? 1u : 0u; mine = (j == x) ? c : mine; }
        if (sum == G) break;
        __builtin_amdgcn_s_sleep(1);
        if ((++sp & 255u) == 0u) { if (xb_ld(&bar[XB_TMO])) break; if (sp > XB_SPIN_CAP) { atomicAdd(&bar[XB_TMO], 1u); break; } }
    }
    nloc = mine > 0u ? mine : 1u; nx = cnt > 0u ? cnt : 1u;
}

__device__ __forceinline__ void xcd_barrier(const XcdBarrier& b) {
    asm volatile("s_waitcnt vmcnt(0)" ::: "memory");
    __syncthreads();
    if (threadIdx.x == 0) {
        unsigned* bar = b.bar;
        __builtin_amdgcn_s_waitcnt(0);
        unsigned nloc = b.st[0], nx = b.st[1];
        if (nloc == 0u) { xcd_barrier_complete(bar, b.x, nloc, nx); b.st[0] = nloc; b.st[1] = nx; }
        const unsigned old = xb_add(&bar[XB_XSUB(b.x)], 1u);
        const unsigned gen = old / nloc;
        if (old + 1u == (gen + 1u) * nloc) {
            __builtin_amdgcn_fence(__ATOMIC_RELEASE, "agent");
            asm volatile("s_waitcnt vmcnt(0)" ::: "memory");
            const unsigned og = xb_add(&bar[XB_TOP], 1u);
            const unsigned tg = og / nx;
            if (og + 1u == (tg + 1u) * nx) xb_add(&bar[XB_TOPGEN], 1u);
            else XB_SPIN(xb_ld(&bar[XB_TOPGEN]) == tg, bar);
            __builtin_amdgcn_fence(__ATOMIC_ACQUIRE, "agent");
            xb_add(&bar[XB_XGEN(b.x)], 1u);
            asm volatile("s_waitcnt vmcnt(0)" ::: "memory");
        } else {
            XB_SPIN(xb_ld(&bar[XB_XGEN(b.x)]) == gen, bar);
            __builtin_amdgcn_fence(__ATOMIC_ACQUIRE, "agent");
            asm volatile("s_waitcnt vmcnt(0)" ::: "memory");
        }
    }
    __syncthreads();
}


using pg8::bf16_t; using pg8::bf16x8; using pg8::f32x4; using pg8::u32x4; using pg8::cvt_pk_bf16;
typedef unsigned u32x2 __attribute__((ext_vector_type(2)));
typedef float f32x2v __attribute__((ext_vector_type(2)));

constexpr int HT = 32768;
constexpr size_t MiB = 1ull << 20;
constexpr size_t WS_W = 0, WS_ROPE = 46 * MiB, WS_XB = 54 * MiB, WS_HB = 182 * MiB, HB_STRIDE = 160 * MiB, WS_U0 = 182 * MiB, WS_CTL = 502 * MiB, WS_RS = 503 * MiB, WS_SS = 504 * MiB, WS_END = 508 * MiB;
constexpr size_t HB_Q = 0, HB_K = 32 * MiB, HB_V = 64 * MiB, HB_SG = 96 * MiB, HB_F = 128 * MiB, HB_RET = HB_K;
constexpr size_t DO_STRIDE = 128 * MiB, DO_KVF = 0, DO_KVB = 32 * MiB, DO_APR = 64 * MiB, DO_API = 96 * MiB, DO_MRG = 0, DO_FOU = 64 * MiB, DO_U1 = 0;
constexpr size_t WO_F1I = 0, WO_F1O = WO_F1I + 5632ull * 1024, WO_WIN = WO_F1O + 1024ull * 2816, WO_RET = WO_WIN + 4608ull * 1024, WO_FFT = WO_RET + 1024ull * 512,
    WO_MIX = WO_FFT + 1024ull * 512, WO_F2I = WO_MIX + 1024ull * 1024, WO_F2O = WO_F2I + 5632ull * 1024, WO_LAYER = WO_F2O + 1024ull * 2816;
constexpr int LDS_TILES = 4 * 34816;
constexpr int LDS_ST = LDS_TILES + 16;
constexpr int LDS_BYTES = LDS_ST + 2048;
constexpr int TP = 272, TREG = 128 * TP;
constexpr float LOG2E = 1.4426950408889634f;
constexpr int NPHASES = 30;

struct Params { const float* in[16]; float* out; unsigned char* ws; int ph_lo, ph_hi; };
#define AS4 __attribute__((address_space(4)))
struct PRef {
    const AS4 Params* kp;
    __device__ __forceinline__ const float* in(int i) const { return kp->in[i]; }
    __device__ __forceinline__ float* out() const { return kp->out; }
    __device__ __forceinline__ unsigned char* ws() const { return kp->ws; }
};

__device__ __forceinline__ float wave_sum(float v) {
#pragma unroll
    for (int o = 1; o < 64; o <<= 1) v += __shfl_xor(v, o);
    return v;
}
__device__ __forceinline__ float silu_f(float x) { return x * __builtin_amdgcn_rcpf(1.0f + __builtin_amdgcn_exp2f(-x * LOG2E)); }
__device__ __forceinline__ float sigm_f(float x) { return __builtin_amdgcn_rcpf(1.0f + __builtin_amdgcn_exp2f(-x * LOG2E)); }
__device__ __forceinline__ float bflo(unsigned w) { return __uint_as_float(w << 16); }
__device__ __forceinline__ float bfhi(unsigned w) { return __uint_as_float(w & 0xffff0000u); }
#define LDS_WAIT() asm volatile("s_waitcnt lgkmcnt(0)" ::: "memory")

__device__ __forceinline__ float sumsq8(const u32x4 v);
struct EpiSwiGLU {
    static constexpr bool PERM = true, AFTER_DRAIN = false;
    bf16_t* U; const float* rs;
    __device__ __forceinline__ void operator()(const f32x4 (&acc)[2][2][4][2], const pg8::Unit& u, int wr, int wc, int fr, int fq) const {
        const int row0 = u.pm * 256 + wr * 64 + fr, col0 = u.pn * 128 + wc * 32 + 8 * fq;
        float rr[2][4];
#pragma unroll
        for (int ai = 0; ai < 2; ++ai)
#pragma unroll
            for (int m = 0; m < 4; ++m) rr[ai][m] = rs[row0 + ai * 128 + m * 16];
#pragma unroll
        for (int ai = 0; ai < 2; ++ai)
#pragma unroll
            for (int m = 0; m < 4; ++m) {
                bf16_t* p = U + (size_t)(row0 + ai * 128 + m * 16) * 2816 + col0;
                const float r = rr[ai][m];
                const f32x4 a0 = acc[ai][0][m][0] * r, a1 = acc[ai][0][m][1] * r, b0 = acc[ai][1][m][0] * r, b1 = acc[ai][1][m][1] * r;
                u32x4 w;
                w.x = cvt_pk_bf16(silu_f(a0[0]) * b0[0], silu_f(a0[1]) * b0[1]); w.y = cvt_pk_bf16(silu_f(a0[2]) * b0[2], silu_f(a0[3]) * b0[3]);
                w.z = cvt_pk_bf16(silu_f(a1[0]) * b1[0], silu_f(a1[1]) * b1[1]); w.w = cvt_pk_bf16(silu_f(a1[2]) * b1[2], silu_f(a1[3]) * b1[3]);
                *(u32x4*)p = w;
            }
    }
};
struct EpiRes {
    static constexpr bool PERM = true, AFTER_DRAIN = false;
    bf16_t* X; float* ss; float scale;
    __device__ __forceinline__ void operator()(const f32x4 (&acc)[2][2][4][2], const pg8::Unit& u, int wr, int wc, int fr, int fq) const {
        const int row0 = u.pm * 256 + wr * 64 + fr, col0 = u.pn * 256 + wc * 32 + 8 * fq;
#pragma unroll
        for (int ai = 0; ai < 2; ++ai) {
            u32x4 xv[4][2];
#pragma unroll
            for (int m = 0; m < 4; ++m)
#pragma unroll
                for (int bj = 0; bj < 2; ++bj) xv[m][bj] = *(const u32x4*)(X + (size_t)(row0 + ai * 128 + m * 16) * 1024 + col0 + bj * 128);
#pragma unroll
            for (int m = 0; m < 4; ++m) {
                float q = 0.f;
#pragma unroll
                for (int bj = 0; bj < 2; ++bj) {
                    const f32x4 v0 = acc[ai][bj][m][0] * scale, v1 = acc[ai][bj][m][1] * scale; const u32x4 x = xv[m][bj];
                    u32x4 w;
                    w.x = cvt_pk_bf16(bflo(x.x) + v0[0], bfhi(x.x) + v0[1]); w.y = cvt_pk_bf16(bflo(x.y) + v0[2], bfhi(x.y) + v0[3]);
                    w.z = cvt_pk_bf16(bflo(x.z) + v1[0], bfhi(x.z) + v1[1]); w.w = cvt_pk_bf16(bflo(x.w) + v1[2], bfhi(x.w) + v1[3]);
                    *(u32x4*)(X + (size_t)(row0 + ai * 128 + m * 16) * 1024 + col0 + bj * 128) = w;
                    q += sumsq8(w);
                }
                q += __shfl_xor(q, 16); q += __shfl_xor(q, 32);
                if (fq == 0) ss[(size_t)(row0 + ai * 128 + m * 16) * 16 + u.pn * 4 + wc] = q;
            }
            asm volatile("" ::: "memory");
        }
    }
};
struct EpiWin {
    static constexpr bool PERM = true, AFTER_DRAIN = false;
    bf16_t* base; const float* rope; const float* rs; int smask;
    __device__ __forceinline__ void operator()(const f32x4 (&acc)[2][2][4][2], const pg8::Unit& u, int wr, int wc, int fr, int fq) const {
        const int pn = u.pn, row0 = u.pm * 256 + wr * 64 + fr;
        if (pn < 4) {
            bf16_t* dstb = base + (size_t)(pn >> 1) * ((size_t)HT * 512);
            const float sc = (pn >> 1) ? 0.08838834764831845f : 1.0f;
            const int head = 2 * (pn & 1) + (wc >> 1), i0 = (wc & 1) * 32 + 8 * fq;
#pragma unroll
            for (int ai = 0; ai < 2; ++ai)
#pragma unroll
                for (int m = 0; m < 4; ++m) {
                    const int row = row0 + ai * 128 + m * 16, pos = row & smask;
                    const f32x4* rp = (const f32x4*)(rope + ((size_t)pos * 64 + i0) * 2);
                    const f32x4 t0 = rp[0], t1 = rp[1], t2 = rp[2], t3 = rp[3];
                    const float scr_ = sc * rs[row];
                    const f32x4 xa = acc[ai][0][m][0] * scr_, xb = acc[ai][0][m][1] * scr_, ya = acc[ai][1][m][0] * scr_, yb = acc[ai][1][m][1] * scr_;
                    u32x4 o1, o2;
                    o1.x = cvt_pk_bf16(xa[0] * t0[0] - ya[0] * t0[1], xa[1] * t0[2] - ya[1] * t0[3]);
                    o1.y = cvt_pk_bf16(xa[2] * t1[0] - ya[2] * t1[1], xa[3] * t1[2] - ya[3] * t1[3]);
                    o1.z = cvt_pk_bf16(xb[0] * t2[0] - yb[0] * t2[1], xb[1] * t2[2] - yb[1] * t2[3]);
                    o1.w = cvt_pk_bf16(xb[2] * t3[0] - yb[2] * t3[1], xb[3] * t3[2] - yb[3] * t3[3]);
                    o2.x = cvt_pk_bf16(xa[0] * t0[1] + ya[0] * t0[0], xa[1] * t0[3] + ya[1] * t0[2]);
                    o2.y = cvt_pk_bf16(xa[2] * t1[1] + ya[2] * t1[0], xa[3] * t1[3] + ya[3] * t1[2]);
                    o2.z = cvt_pk_bf16(xb[0] * t2[1] + yb[0] * t2[0], xb[1] * t2[3] + yb[1] * t2[2]);
                    o2.w = cvt_pk_bf16(xb[2] * t3[1] + yb[2] * t3[0], xb[3] * t3[3] + yb[3] * t3[2]);
                    bf16_t* p = dstb + (size_t)row * 512 + head * 128 + i0;
                    *(u32x4*)p = o1; *(u32x4*)(p + 64) = o2;
                    if (m & 1) asm volatile("" ::: "memory");
                }
        } else {
            const int b = pn >> 1;
            bf16_t* dstb = base + (size_t)b * ((size_t)HT * 512);
            const int col0 = (pn & 1) * 256 + wc * 32 + 8 * fq;
#pragma unroll
            for (int ai = 0; ai < 2; ++ai)
#pragma unroll
                for (int m = 0; m < 4; ++m) {
                    bf16_t* p = dstb + (size_t)(row0 + ai * 128 + m * 16) * 512 + col0;
                    const float r = rs[row0 + ai * 128 + m * 16];
#pragma unroll
                    for (int bj = 0; bj < 2; ++bj) {
                        f32x4 v0 = acc[ai][bj][m][0] * r, v1 = acc[ai][bj][m][1] * r;
                        if (b == 3) {
#pragma unroll
                            for (int j = 0; j < 4; ++j) { v0[j] = silu_f(v0[j]); v1[j] = silu_f(v1[j]); }
                        }
                        u32x4 w; w.x = cvt_pk_bf16(v0[0], v0[1]); w.y = cvt_pk_bf16(v0[2], v0[3]); w.z = cvt_pk_bf16(v1[0], v1[1]); w.w = cvt_pk_bf16(v1[2], v1[3]);
                        *(u32x4*)(p + bj * 128) = w;
                    }
                }
        }
    }
};
struct EpiBf {
    static constexpr bool PERM = true, AFTER_DRAIN = false;
    bf16_t* O;
    __device__ __forceinline__ void operator()(const f32x4 (&acc)[2][2][4][2], const pg8::Unit& u, int wr, int wc, int fr, int fq) const {
        const int row0 = u.pm * 256 + wr * 64 + fr, col0 = u.pn * 256 + wc * 32 + 8 * fq;
#pragma unroll
        for (int ai = 0; ai < 2; ++ai)
#pragma unroll
            for (int m = 0; m < 4; ++m) {
                bf16_t* p = O + (size_t)(row0 + ai * 128 + m * 16) * 1024 + col0;
#pragma unroll
                for (int bj = 0; bj < 2; ++bj) {
                    const f32x4 v0 = acc[ai][bj][m][0], v1 = acc[ai][bj][m][1];
                    u32x4 w; w.x = cvt_pk_bf16(v0[0], v0[1]); w.y = cvt_pk_bf16(v0[2], v0[3]); w.z = cvt_pk_bf16(v1[0], v1[1]); w.w = cvt_pk_bf16(v1[2], v1[3]);
                    *(u32x4*)(p + bj * 128) = w;
                }
            }
    }
};
struct EpiGates {
    static constexpr bool PERM = true, AFTER_DRAIN = false;
    const bf16_t* RET; const bf16_t* FOU; bf16_t* MRG; const float* rs;
    __device__ __forceinline__ void operator()(const f32x4 (&acc)[2][2][4][2], const pg8::Unit& u, int wr, int wc, int fr, int fq) const {
        const int row0 = u.pm * 256 + wr * 64 + fr, col0 = u.pn * 128 + wc * 32 + 8 * fq;
#pragma unroll
        for (int ai = 0; ai < 2; ++ai) {
            u32x4 rv[4], fv[4];
#pragma unroll
            for (int m = 0; m < 4; ++m) { const size_t off = (size_t)(row0 + ai * 128 + m * 16) * 1024 + col0; rv[m] = *(const u32x4*)(RET + off); fv[m] = *(const u32x4*)(FOU + off); }
#pragma unroll
            for (int m = 0; m < 4; ++m) {
                const size_t off = (size_t)(row0 + ai * 128 + m * 16) * 1024 + col0;
                const float r = rs[row0 + ai * 128 + m * 16];
                const f32x4 g0 = acc[ai][0][m][0] * r, g1 = acc[ai][0][m][1] * r, h0 = acc[ai][1][m][0] * r, h1 = acc[ai][1][m][1] * r;
                u32x4 w;
                w.x = cvt_pk_bf16(sigm_f(g0[0]) * bflo(rv[m].x) + sigm_f(h0[0]) * bflo(fv[m].x), sigm_f(g0[1]) * bfhi(rv[m].x) + sigm_f(h0[1]) * bfhi(fv[m].x));
                w.y = cvt_pk_bf16(sigm_f(g0[2]) * bflo(rv[m].y) + sigm_f(h0[2]) * bflo(fv[m].y), sigm_f(g0[3]) * bfhi(rv[m].y) + sigm_f(h0[3]) * bfhi(fv[m].y));
                w.z = cvt_pk_bf16(sigm_f(g1[0]) * bflo(rv[m].z) + sigm_f(h1[0]) * bflo(fv[m].z), sigm_f(g1[1]) * bfhi(rv[m].z) + sigm_f(h1[1]) * bfhi(fv[m].z));
                w.w = cvt_pk_bf16(sigm_f(g1[2]) * bflo(rv[m].w) + sigm_f(h1[2]) * bflo(fv[m].w), sigm_f(g1[3]) * bfhi(rv[m].w) + sigm_f(h1[3]) * bfhi(fv[m].w));
                *(u32x4*)(MRG + off) = w;
            }
            asm volatile("" ::: "memory");
        }
    }
};
template <class Epi, bool ALIGN = GEMM_ALIGN>
__device__ __forceinline__ void run_gemm(LAS unsigned char* lds, const bf16_t* A, const bf16_t* Bt, int M, int N, int K, const Epi& E) {
    pg8::Gemm g; g.A = A; g.Bt = Bt; g.M = M; g.N = N; g.K = K;
    pg8::StaticOrder S; S.init(M, N, (int)gridDim.x, (int)blockIdx.x);
    pg8::gemm_phase<Epi, pg8::StaticOrder, ALIGN, GEMM_SP2>(lds, g, S, E);
    __syncthreads();
}

__device__ __forceinline__ int src_col(int kind, int n) {
    if (kind == 0) return n;
    const int t = n >> 8, r = n & 255;
    if (kind == 1) return (r < 128) ? (t * 128 + r) : (2816 + t * 128 + (r - 128));
    if (t < 4) { const int hi = r >> 7, rr = r & 127, hl = rr >> 6, i = rr & 63, head = 2 * (t & 1) + hl; return (t >> 1) * 512 + head * 128 + 2 * i + hi; }
    if (t < 10) return n;
    const int tg = t - 10; return (r < 128) ? (2560 + tg * 128 + r) : (3584 + tg * 128 + (r - 128));
}
__device__ __forceinline__ void transpose_item(const float* W, int K, int N, bf16_t* WT, int kind, LAS float* scr, int item, int lane, const float* g = nullptr) {
    const int nblk = N / 32, kb = item / nblk, nb = item % nblk, k0 = 64 * kb, n0 = 32 * nb;
    const int sc = src_col(kind, n0 + (lane & 31));
#pragma unroll 8
    for (int i = 0; i < 32; ++i) { const int kk = 2 * i + (lane >> 5); float w = W[(size_t)(k0 + kk) * N + sc]; if (g) w *= g[k0 + kk]; scr[kk * 33 + (lane & 31)] = w; }
    LDS_WAIT();
    const int c = lane & 7;
#pragma unroll
    for (int j = 0; j < 4; ++j) {
        const int n = (lane >> 3) + 8 * j; const LAS float* s = scr + (8 * c) * 33 + n;
        u32x4 o; o.x = cvt_pk_bf16(s[0 * 33], s[1 * 33]); o.y = cvt_pk_bf16(s[2 * 33], s[3 * 33]); o.z = cvt_pk_bf16(s[4 * 33], s[5 * 33]); o.w = cvt_pk_bf16(s[6 * 33], s[7 * 33]);
        *(u32x4*)(WT + (size_t)(n0 + n) * K + k0 + 8 * c) = o;
    }
    LDS_WAIT();
}
__device__ __forceinline__ void phase_prep(const PRef& p, LAS unsigned char* lds, int l, int grp) {
    int tid_ = threadIdx.x; asm volatile("" : "+v"(tid_)); const int tid = tid_, wave = tid >> 6, lane = tid & 63;
    LAS float* scr = (LAS float*)(lds + wave * 8448);
    bf16_t* W = (bf16_t*)(p.ws() + WS_W);
    const int gw = blockIdx.x * 8 + wave, ngw = gridDim.x * 8;
    constexpr int I_FI = 16 * 176, I_FO = 44 * 32, I_WIN = 16 * 144, I_RO = 8 * 32, I_MX = 16 * 32, I_LAYER = 2 * I_FI + 2 * I_FO + I_WIN + 2 * I_RO + I_MX;
    constexpr int I_A = I_FI + I_FO + I_WIN + 2 * I_RO + I_MX;
    const int it0 = (grp & 1) ? 0 : I_A, it1 = (grp & 2) ? I_LAYER : I_A;
    for (int it = it0 + gw; it < it1; it += ngw) {
        int r = it;
        bf16_t* Wl = W;
        if (r < I_FI) { transpose_item(p.in(3) + (size_t)l * 1024 * 5632, 1024, 5632, Wl + WO_F1I, 1, scr, r, lane, p.in(2) + l * 1024); continue; } r -= I_FI;
        if (r < I_FO) { transpose_item(p.in(4) + (size_t)l * 2816 * 1024, 2816, 1024, Wl + WO_F1O, 0, scr, r, lane); continue; } r -= I_FO;
        if (r < I_WIN) { transpose_item(p.in(6) + (size_t)l * 1024 * 4608, 1024, 4608, Wl + WO_WIN, 2, scr, r, lane, p.in(5) + l * 1024); continue; } r -= I_WIN;
        if (r < I_RO) { transpose_item(p.in(9) + (size_t)l * 512 * 1024, 512, 1024, Wl + WO_RET, 0, scr, r, lane); continue; } r -= I_RO;
        if (r < I_RO) { transpose_item(p.in(10) + (size_t)l * 512 * 1024, 512, 1024, Wl + WO_FFT, 0, scr, r, lane); continue; } r -= I_RO;
        if (r < I_MX) { transpose_item(p.in(11) + (size_t)l * 1024 * 1024, 1024, 1024, Wl + WO_MIX, 0, scr, r, lane); continue; } r -= I_MX;
        if (r < I_FI) { transpose_item(p.in(13) + (size_t)l * 1024 * 5632, 1024, 5632, Wl + WO_F2I, 1, scr, r, lane, p.in(12) + l * 1024); continue; } r -= I_FI;
        transpose_item(p.in(14) + (size_t)l * 2816 * 1024, 2816, 1024, Wl + WO_F2O, 0, scr, r, lane);
    }
    if (!(grp & 4)) return;
    f32x2v* rope = (f32x2v*)(p.ws() + WS_ROPE);
    for (int idx = blockIdx.x * 512 + tid; idx < 16384 * 64; idx += gridDim.x * 512) {
        const int pos = idx >> 6, i = idx & 63;
        double f = 1.0;
        for (int q = 0; q < i; ++q) f *= 0.8639884494839686;
        const float inv = (float)f, ang = (float)pos * inv;
        double rev = (double)ang * 0.15915494309189535; rev -= __builtin_floor(rev);
        const float fr = (float)rev;
        f32x2v o; o.x = __builtin_amdgcn_cosf(fr); o.y = __builtin_amdgcn_sinf(fr);
        rope[idx] = o;
    }
}

__device__ __forceinline__ void rows_init(const float* src, bf16_t* xb, float* rs, int nrows) {
    int tid_ = threadIdx.x; asm volatile("" : "+v"(tid_)); const int tid = tid_, wave = tid >> 6, lane = tid & 63;
    for (int row = blockIdx.x * 8 + wave; row < nrows; row += gridDim.x * 8) {
        const f32x4* xr = (const f32x4*)(src + (size_t)row * 1024) + lane;
        const f32x4 v0 = xr[0], v1 = xr[64], v2 = xr[128], v3 = xr[192];
        float s = (v0[0] * v0[0] + v0[1] * v0[1]) + (v0[2] * v0[2] + v0[3] * v0[3]);
        s += (v1[0] * v1[0] + v1[1] * v1[1]) + (v1[2] * v1[2] + v1[3] * v1[3]);
        s += (v2[0] * v2[0] + v2[1] * v2[1]) + (v2[2] * v2[2] + v2[3] * v2[3]);
        s += (v3[0] * v3[0] + v3[1] * v3[1]) + (v3[2] * v3[2] + v3[3] * v3[3]);
        const float rstd = 1.0f / sqrtf(wave_sum(s) * (1.0f / 1024.0f) + 1e-6f);
        if (lane == 0) rs[row] = rstd;
        u32x2* o = (u32x2*)(xb + (size_t)row * 1024) + lane;
        u32x2 w; w.x = cvt_pk_bf16(v0[0], v0[1]); w.y = cvt_pk_bf16(v0[2], v0[3]); o[0] = w;
        w.x = cvt_pk_bf16(v1[0], v1[1]); w.y = cvt_pk_bf16(v1[2], v1[3]); o[64] = w;
        w.x = cvt_pk_bf16(v2[0], v2[1]); w.y = cvt_pk_bf16(v2[2], v2[3]); o[128] = w;
        w.x = cvt_pk_bf16(v3[0], v3[1]); w.y = cvt_pk_bf16(v3[2], v3[3]); o[192] = w;
    }
}
__device__ __forceinline__ float sumsq8(const u32x4 v) {
    return (bflo(v.x) * bflo(v.x) + bfhi(v.x) * bfhi(v.x)) + (bflo(v.y) * bflo(v.y) + bfhi(v.y) * bfhi(v.y)) + (bflo(v.z) * bflo(v.z) + bfhi(v.z) * bfhi(v.z)) + (bflo(v.w) * bflo(v.w) + bfhi(v.w) * bfhi(v.w));
}
__device__ __forceinline__ void rowstat(const bf16_t* xb, float* rs, int nrows) {
    int tid_ = threadIdx.x; asm volatile("" : "+v"(tid_)); const int tid = tid_, wave = tid >> 6, lane = tid & 63;
    for (int row0 = (blockIdx.x * 8 + wave) * 2; row0 < nrows; row0 += gridDim.x * 16) {
        const u32x4* r0 = (const u32x4*)(xb + (size_t)row0 * 1024) + lane;
        const u32x4 a0 = r0[0], a1 = r0[64], b0 = r0[128], b1 = r0[192];
        const float s0 = wave_sum(sumsq8(a0) + sumsq8(a1)), s1 = wave_sum(sumsq8(b0) + sumsq8(b1));
        if (lane == 0) { rs[row0] = 1.0f / sqrtf(s0 * (1.0f / 1024.0f) + 1e-6f); rs[row0 + 1] = 1.0f / sqrtf(s1 * (1.0f / 1024.0f) + 1e-6f); }
    }
}
__device__ __forceinline__ void rowstat_slots(const float* ss, float* rs, int nrows) {
    int tid_ = threadIdx.x; asm volatile("" : "+v"(tid_));
    for (int row = blockIdx.x * 512 + tid_; row < nrows; row += gridDim.x * 512) {
        const f32x4* p4 = (const f32x4*)(ss + (size_t)row * 16);
        const f32x4 a = p4[0], b = p4[1], c = p4[2], d = p4[3];
        const float s = ((a[0] + a[1]) + (a[2] + a[3])) + ((b[0] + b[1]) + (b[2] + b[3])) + ((c[0] + c[1]) + (c[2] + c[3])) + ((d[0] + d[1]) + (d[2] + d[3]));
        rs[row] = 1.0f / sqrtf(s * (1.0f / 1024.0f) + 1e-6f);
    }
}
__device__ __forceinline__ void final_norm(const bf16_t* xb, const float* g, float* out, int nrows) {
    int tid_ = threadIdx.x; asm volatile("" : "+v"(tid_)); const int tid = tid_, wave = tid >> 6, lane = tid & 63;
    const f32x4* gp = (const f32x4*)g + 2 * lane;
    const f32x4 g0 = gp[0], g1 = gp[1], g2 = gp[128], g3 = gp[129];
    for (int row = blockIdx.x * 8 + wave; row < nrows; row += gridDim.x * 8) {
        const u32x4* r0 = (const u32x4*)(xb + (size_t)row * 1024) + lane;
        const u32x4 a = r0[0], b = r0[64];
        const float rstd = 1.0f / sqrtf(wave_sum(sumsq8(a) + sumsq8(b)) * (1.0f / 1024.0f) + 1e-6f);
        f32x4* o = (f32x4*)(out + (size_t)row * 1024) + 2 * lane;
        o[0] = (f32x4){bflo(a.x), bfhi(a.x), bflo(a.y), bfhi(a.y)} * rstd * g0; o[1] = (f32x4){bflo(a.z), bfhi(a.z), bflo(a.w), bfhi(a.w)} * rstd * g1;
        o[128] = (f32x4){bflo(b.x), bfhi(b.x), bflo(b.y), bfhi(b.y)} * rstd * g2; o[129] = (f32x4){bflo(b.z), bfhi(b.z), bflo(b.w), bfhi(b.w)} * rstd * g3;
    }
}

__device__ __forceinline__ void mm_tile(f32x4 (&acc)[2][4], const LAS unsigned char* A, const LAS unsigned char* B, int wr, int wc, int fr, int fq, int ksteps) {
    const LAS unsigned char* ap = A + (32 * wr + fr) * TP + fq * 16;
    const LAS unsigned char* bp = B + (64 * wc + fr) * TP + fq * 16;
    bf16x8 a[2], b[4];
#pragma unroll
    for (int mi = 0; mi < 2; ++mi) a[mi] = *(const LAS bf16x8*)(ap + mi * 16 * TP);
#pragma unroll
    for (int ni = 0; ni < 4; ++ni) b[ni] = *(const LAS bf16x8*)(bp + ni * 16 * TP);
#pragma unroll 1
    for (int ks = 0; ks < ksteps; ++ks) {
        bf16x8 an[2], bn[4];
        const int kn = (ks + 1 < ksteps) ? (ks + 1) : ks;
#pragma unroll
        for (int mi = 0; mi < 2; ++mi) an[mi] = *(const LAS bf16x8*)(ap + mi * 16 * TP + kn * 64);
#pragma unroll
        for (int ni = 0; ni < 4; ++ni) bn[ni] = *(const LAS bf16x8*)(bp + ni * 16 * TP + kn * 64);
#pragma unroll
        for (int mi = 0; mi < 2; ++mi)
#pragma unroll
            for (int ni = 0; ni < 4; ++ni) acc[mi][ni] = __builtin_amdgcn_mfma_f32_16x16x32_bf16(b[ni], a[mi], acc[mi][ni], 0, 0, 0);
#pragma unroll
        for (int mi = 0; mi < 2; ++mi) a[mi] = an[mi];
#pragma unroll
        for (int ni = 0; ni < 4; ++ni) b[ni] = bn[ni];
    }
}
__device__ __forceinline__ void zero_acc(f32x4 (&acc)[2][4]) {
#pragma unroll
    for (int mi = 0; mi < 2; ++mi)
#pragma unroll
        for (int ni = 0; ni < 4; ++ni) acc[mi][ni] = (f32x4){0.f, 0.f, 0.f, 0.f};
}
__device__ __forceinline__ void load_nat(LAS unsigned char* dst, const bf16_t* src, size_t ld, int nrows, int tid) {
    for (int id = tid; id < nrows * 16; id += 512) { const int row = id >> 4, c = id & 15; const u32x4 v = *(const u32x4*)(src + (size_t)row * ld + c * 8); *(LAS u32x4*)(dst + row * TP + c * 16) = v; }
}
__device__ __forceinline__ void tr_issue(u32x4 (&r)[4], const bf16_t* src, size_t ld, int nrows, int tid);
__device__ __forceinline__ void tr_commit(LAS unsigned char* dst, const u32x4 (&r)[4], int nrows, int tid);
__device__ __forceinline__ void load_tr(LAS unsigned char* dst, const bf16_t* src, size_t ld, int nrows, int tid) {
    u32x4 r[4]; tr_issue(r, src, ld, nrows, tid); tr_commit(dst, r, nrows, tid);
}
__device__ __forceinline__ void tr_issue(u32x4 (&r)[4], const bf16_t* src, size_t ld, int nrows, int tid) {
    const int ng = nrows >> 2, g = tid & (ng - 1), c = (nrows == 128) ? (tid >> 5) : (tid >> 4);
    if (c < 16) {
#pragma unroll
        for (int q = 0; q < 4; ++q) r[q] = *(const u32x4*)(src + (size_t)(4 * g + q) * ld + c * 8);
    }
}
__device__ __forceinline__ void tr_commit(LAS unsigned char* dst, const u32x4 (&r)[4], int nrows, int tid) {
    const int ng = nrows >> 2, g = tid & (ng - 1), c = (nrows == 128) ? (tid >> 5) : (tid >> 4);
    if (c < 16) {
        LAS unsigned char* d = dst + (8 * c) * TP + g * 8;
#pragma unroll
        for (int w = 0; w < 4; ++w) {
            const unsigned a0 = r[0][w], a1 = r[1][w], a2 = r[2][w], a3 = r[3][w];
            u32x2 lo, hi;
            lo.x = (a0 & 0xffffu) | (a1 << 16); lo.y = (a2 & 0xffffu) | (a3 << 16);
            hi.x = (a0 >> 16) | (a1 & 0xffff0000u); hi.y = (a2 >> 16) | (a3 & 0xffff0000u);
            *(LAS u32x2*)(d + (2 * w) * TP) = lo; *(LAS u32x2*)(d + (2 * w + 1) * TP) = hi;
        }
    }
}
__device__ __forceinline__ void nat_issue(u32x4 (&r)[4], const bf16_t* src, size_t ld, int tid) {
#pragma unroll
    for (int q = 0; q < 4; ++q) { const int id = tid + 512 * q, row = id >> 4, c = id & 15; r[q] = *(const u32x4*)(src + (size_t)row * ld + c * 8); }
}
__device__ __forceinline__ void nat_commit(LAS unsigned char* dst, const u32x4 (&r)[4], int tid) {
#pragma unroll
    for (int q = 0; q < 4; ++q) { const int id = tid + 512 * q, row = id >> 4, c = id & 15; *(LAS u32x4*)(dst + row * TP + c * 16) = r[q]; }
}
__device__ __forceinline__ void store_acc_bf16(bf16_t* dst, size_t ld, const f32x4 (&acc)[2][4], int wr, int wc, int fr, int fq) {
#pragma unroll
    for (int mi = 0; mi < 2; ++mi)
#pragma unroll
        for (int ni = 0; ni < 4; ++ni) {
            u32x2 w; w.x = cvt_pk_bf16(acc[mi][ni][0], acc[mi][ni][1]); w.y = cvt_pk_bf16(acc[mi][ni][2], acc[mi][ni][3]);
            *(u32x2*)(dst + (size_t)(32 * wr + 16 * mi + fr) * ld + 64 * wc + 16 * ni + 4 * fq) = w;
        }
}
__device__ __forceinline__ void store_acc_lds(LAS unsigned char* dst, const f32x4 (&acc)[2][4], int wr, int wc, int fr, int fq) {
#pragma unroll
    for (int mi = 0; mi < 2; ++mi)
#pragma unroll
        for (int ni = 0; ni < 4; ++ni) {
            u32x2 w; w.x = cvt_pk_bf16(acc[mi][ni][0], acc[mi][ni][1]); w.y = cvt_pk_bf16(acc[mi][ni][2], acc[mi][ni][3]);
            *(LAS u32x2*)(dst + (32 * wr + 16 * mi + fr) * TP + (64 * wc + 16 * ni + 4 * fq) * 2) = w;
        }
}

__device__ __forceinline__ void phase_RA(const PRef& p, LAS unsigned char* lds, int l, int h) {
    int tid_ = threadIdx.x; asm volatile("" : "+v"(tid_)); const int tid = tid_, wid = tid >> 6, lane = tid & 63, wr = wid >> 1, wc = wid & 1, fr = lane & 15, fq = lane >> 4;
    unsigned char* hb = p.ws() + WS_HB + (size_t)h * HB_STRIDE; unsigned char* db = (unsigned char*)p.out() + (size_t)h * DO_STRIDE;
    const bf16_t* Kb = (const bf16_t*)(hb + HB_K);
    const bf16_t* Vb = (const bf16_t*)(hb + HB_V);
    bf16_t* KVF = (bf16_t*)(db + DO_KVF); bf16_t* KVB = (bf16_t*)(db + DO_KVB);
    LAS unsigned char* R0 = lds; LAS unsigned char* R1 = lds + TREG; LAS unsigned char* R2 = lds + 2 * TREG;
    u32x4 kvr[4], vvr[4];
    const int g4 = tid & 31, cc = tid >> 5;
    if (blockIdx.x < 1024) {
        const int u = blockIdx.x, c = u >> 2, hd = u & 3;
        tr_issue(kvr, Kb + (size_t)(c * 128) * 512 + hd * 128, 512, 128, tid); tr_issue(vvr, Vb + (size_t)(c * 128) * 512 + hd * 128, 512, 128, tid);
    }
    for (int u = blockIdx.x; u < 1024; u += gridDim.x) {
        const int hd = u & 3;
        const float lf2 = p.in(7)[l * 4 + hd] * LOG2E, lb2 = p.in(8)[l * 4 + hd] * LOG2E;
        tr_commit(R0, vvr, 128, tid);
        {
            float df[4], dbk[4];
#pragma unroll
            for (int q = 0; q < 4; ++q) { const int j = 4 * g4 + q; df[q] = __builtin_amdgcn_exp2f(lf2 * (float)(127 - j)); dbk[q] = __builtin_amdgcn_exp2f(lb2 * (float)(j + 1)); }
            const int o = (8 * cc) * TP + g4 * 8;
#pragma unroll
            for (int w = 0; w < 4; ++w) {
                const unsigned a0 = kvr[0][w], a1 = kvr[1][w], a2 = kvr[2][w], a3 = kvr[3][w];
                u32x2 t;
                t.x = cvt_pk_bf16(bflo(a0) * df[0], bflo(a1) * df[1]); t.y = cvt_pk_bf16(bflo(a2) * df[2], bflo(a3) * df[3]); *(LAS u32x2*)(R1 + o + (2 * w) * TP) = t;
                t.x = cvt_pk_bf16(bfhi(a0) * df[0], bfhi(a1) * df[1]); t.y = cvt_pk_bf16(bfhi(a2) * df[2], bfhi(a3) * df[3]); *(LAS u32x2*)(R1 + o + (2 * w + 1) * TP) = t;
                t.x = cvt_pk_bf16(bflo(a0) * dbk[0], bflo(a1) * dbk[1]); t.y = cvt_pk_bf16(bflo(a2) * dbk[2], bflo(a3) * dbk[3]); *(LAS u32x2*)(R2 + o + (2 * w) * TP) = t;
                t.x = cvt_pk_bf16(bfhi(a0) * dbk[0], bfhi(a1) * dbk[1]); t.y = cvt_pk_bf16(bfhi(a2) * dbk[2], bfhi(a3) * dbk[3]); *(LAS u32x2*)(R2 + o + (2 * w + 1) * TP) = t;
            }
        }
        __syncthreads();
        { const int un = u + gridDim.x; if (un < 1024) {
            const int c = un >> 2, hdn = un & 3;
            tr_issue(kvr, Kb + (size_t)(c * 128) * 512 + hdn * 128, 512, 128, tid); tr_issue(vvr, Vb + (size_t)(c * 128) * 512 + hdn * 128, 512, 128, tid);
        } }
        f32x4 acc[2][4];
        zero_acc(acc); mm_tile(acc, R0, R1, wr, wc, fr, fq, 4); store_acc_bf16(KVF + (size_t)u * 16384, 128, acc, wr, wc, fr, fq);
        zero_acc(acc); mm_tile(acc, R0, R2, wr, wc, fr, fq, 4); store_acc_bf16(KVB + (size_t)u * 16384, 128, acc, wr, wc, fr, fq);
        __syncthreads();
    }
}
__device__ __forceinline__ void phase_RB(const PRef& p, int l, int h) {
    const int nseq = h ? 4 : 2, ncs = h ? 64 : 128;
    const int ntasks = nseq * 65536;
    int tid_ = threadIdx.x; asm volatile("" : "+v"(tid_));
    for (int task = blockIdx.x * 512 + tid_; task < ntasks; task += gridDim.x * 512) {
        const int pp = task & 8191, dir = (task >> 13) & 1, hd = (task >> 14) & 3, seq = task >> 16;
        unsigned* base = (unsigned*)((unsigned char*)p.out() + (size_t)h * DO_STRIDE + (dir ? DO_KVB : DO_KVF)) + ((size_t)(seq * ncs) * 4 + hd) * 8192 + pp;
        const float ld = dir ? p.in(8)[l * 4 + hd] : p.in(7)[l * 4 + hd];
        const float dec = __builtin_amdgcn_exp2f(ld * LOG2E * 128.0f);
        float s0 = 0.f, s1 = 0.f;
        for (int c0 = 0; c0 < ncs; c0 += 32) {
            unsigned v[32];
#pragma unroll
            for (int i = 0; i < 32; ++i) { const int cc = dir ? (ncs - 1 - (c0 + i)) : (c0 + i); v[i] = base[(size_t)cc * 32768]; }
#pragma unroll
            for (int i = 0; i < 32; ++i) { const int cc = dir ? (ncs - 1 - (c0 + i)) : (c0 + i); base[(size_t)cc * 32768] = cvt_pk_bf16(s0, s1); s0 = s0 * dec + bflo(v[i]); s1 = s1 * dec + bfhi(v[i]); }
        }
    }
}
__device__ __forceinline__ void phase_RC(const PRef& p, LAS unsigned char* lds, int l, int h) {
    int tid_ = threadIdx.x; asm volatile("" : "+v"(tid_)); const int tid = tid_, wid = tid >> 6, lane = tid & 63, wr = wid >> 1, wc = wid & 1, fr = lane & 15, fq = lane >> 4;
    unsigned char* hb = p.ws() + WS_HB + (size_t)h * HB_STRIDE; unsigned char* db = (unsigned char*)p.out() + (size_t)h * DO_STRIDE;
    const bf16_t* Qb = (const bf16_t*)(hb + HB_Q);
    const bf16_t* Kb = (const bf16_t*)(hb + HB_K); const bf16_t* Vb = (const bf16_t*)(hb + HB_V); const bf16_t* SGb = (const bf16_t*)(hb + HB_SG);
    const bf16_t* KVF = (const bf16_t*)(db + DO_KVF); const bf16_t* KVB = (const bf16_t*)(db + DO_KVB);
    bf16_t* Rb = (bf16_t*)(hb + HB_Q);
    LAS unsigned char* R0 = lds; LAS unsigned char* R1 = lds + TREG; LAS unsigned char* R2 = lds + 2 * TREG; LAS unsigned char* R3 = lds + 3 * TREG;
    for (int u = blockIdx.x; u < 1024; u += gridDim.x) {
        const int c = u >> 2, hd = u & 3;
        const float lf2 = p.in(7)[l * 4 + hd] * LOG2E, lb2 = p.in(8)[l * 4 + hd] * LOG2E;
        const size_t toff = (size_t)(c * 128) * 512 + hd * 128;
        load_nat(R0, Qb + toff, 512, 128, tid); load_nat(R1, Kb + toff, 512, 128, tid); load_tr(R2, Vb + toff, 512, 128, tid); load_nat(R3, KVF + (size_t)u * 16384, 128, 128, tid);
        __syncthreads();
        f32x4 accS[2][4], accY[2][4];
        u32x4 sbr[4]; nat_issue(sbr, KVB + (size_t)u * 16384, 128, tid);
        zero_acc(accS); mm_tile(accS, R0, R1, wr, wc, fr, fq, 4);
        zero_acc(accY); mm_tile(accY, R0, R3, wr, wc, fr, fq, 4);
        __syncthreads();
#pragma unroll
        for (int mi = 0; mi < 2; ++mi) {
            const int i = 32 * wr + 16 * mi + fr;
            const float af = __builtin_amdgcn_exp2f(lf2 * (float)(i + 1));
#pragma unroll
            for (int ni = 0; ni < 4; ++ni) {
                const int j0 = 64 * wc + 16 * ni + 4 * fq;
                float pv[4];
#pragma unroll
                for (int jj = 0; jj < 4; ++jj) { const int d = i - (j0 + jj); const float w = (d >= 0) ? __builtin_amdgcn_exp2f(lf2 * (float)d) : __builtin_amdgcn_exp2f(lb2 * (float)(-d)); pv[jj] = accS[mi][ni][jj] * w; }
                u32x2 w2; w2.x = cvt_pk_bf16(pv[0], pv[1]); w2.y = cvt_pk_bf16(pv[2], pv[3]);
                *(LAS u32x2*)(R1 + i * TP + j0 * 2) = w2;
                accY[mi][ni] = accY[mi][ni] * af;
            }
        }
        nat_commit(R3, sbr, tid);
        __syncthreads();
        mm_tile(accY, R1, R2, wr, wc, fr, fq, 4);
        f32x4 acc3[2][4];
        zero_acc(acc3); mm_tile(acc3, R0, R3, wr, wc, fr, fq, 4);
        LAS f32x2v* st = (LAS f32x2v*)(lds + LDS_ST);
#pragma unroll
        for (int mi = 0; mi < 2; ++mi) {
            const int i = 32 * wr + 16 * mi + fr;
            const float ab = __builtin_amdgcn_exp2f(lb2 * (float)(127 - i));
            float s = 0.f, q = 0.f;
#pragma unroll
            for (int ni = 0; ni < 4; ++ni) {
                const f32x4 y = accY[mi][ni] + ab * acc3[mi][ni];
                accY[mi][ni] = y;
                s += (y[0] + y[1]) + (y[2] + y[3]); q += (y[0] * y[0] + y[1] * y[1]) + (y[2] * y[2] + y[3] * y[3]);
            }
            s += __shfl_xor(s, 16); s += __shfl_xor(s, 32); q += __shfl_xor(q, 16); q += __shfl_xor(q, 32);
            if (fq == 0) st[i * 2 + wc] = (f32x2v){s, q};
        }
        __syncthreads();
#pragma unroll
        for (int mi = 0; mi < 2; ++mi) {
            const int i = 32 * wr + 16 * mi + fr;
            const f32x2v a = st[i * 2 + 0], b = st[i * 2 + 1];
            const float mean = (a.x + b.x) * (1.0f / 128.0f), var = (a.y + b.y) * (1.0f / 128.0f) - mean * mean;
            const float rs = 1.0f / sqrtf(fmaxf(var, 0.f) + 1e-6f);
#pragma unroll
            for (int ni = 0; ni < 4; ++ni) {
                const size_t off = toff + (size_t)i * 512 + 64 * wc + 16 * ni + 4 * fq;
                const u32x2 sg = *(const u32x2*)(SGb + off);
                const f32x4 y = accY[mi][ni];
                u32x2 w2; w2.x = cvt_pk_bf16(bflo(sg.x) * (y[0] - mean) * rs, bfhi(sg.x) * (y[1] - mean) * rs); w2.y = cvt_pk_bf16(bflo(sg.y) * (y[2] - mean) * rs, bfhi(sg.y) * (y[3] - mean) * rs);
                *(u32x2*)(Rb + off) = w2;
            }
        }
        __syncthreads();
    }
}

__device__ __forceinline__ void fill_dft(LAS unsigned char* R0, LAS unsigned char* R1, int N, int tid) {
    const int sh = (N == 128) ? 7 : 6;
    const float invN = 1.0f / (float)N;
    for (int idx = tid; idx < N * N; idx += 512) {
        const int k = idx >> sh, n = idx & (N - 1);
        const float a = (float)((k * n) & (N - 1)) * invN;
        const unsigned pk = cvt_pk_bf16(__builtin_amdgcn_cosf(a), __builtin_amdgcn_sinf(a));
        *(LAS unsigned short*)(R0 + k * TP + n * 2) = (unsigned short)(pk & 0xffffu);
        *(LAS unsigned short*)(R1 + k * TP + n * 2) = (unsigned short)(pk >> 16);
    }
}
__device__ __forceinline__ void phase_FA(const PRef& p, LAS unsigned char* lds, int h) {
    int tid_ = threadIdx.x; asm volatile("" : "+v"(tid_)); const int tid = tid_, wid = tid >> 6, lane = tid & 63, wr = wid >> 1, wc = wid & 1, fr = lane & 15, fq = lane >> 4;
    const int N1 = h ? 64 : 128, nseq = h ? 4 : 2, S = N1 * 128, nunits = nseq * 512, ksteps = N1 / 32;
    const float invS = 1.0f / (float)S;
    const bf16_t* Fb = (const bf16_t*)(p.ws() + WS_HB + (size_t)h * HB_STRIDE + HB_F);
    unsigned char* db = (unsigned char*)p.out() + (size_t)h * DO_STRIDE;
    bf16_t* APR = (bf16_t*)(db + DO_APR); bf16_t* API = (bf16_t*)(db + DO_API);
    LAS unsigned char* R0 = lds; LAS unsigned char* R1 = lds + TREG; LAS unsigned char* R2 = lds + 2 * TREG;
    fill_dft(R0, R1, N1, tid);
    __syncthreads();
    u32x4 pf[4];
    if ((int)blockIdx.x < nunits) { const int u = blockIdx.x, g = u & 3, n2 = (u >> 2) & 127, seq = u >> 9; tr_issue(pf, Fb + ((size_t)seq * S + n2) * 512 + g * 128, (size_t)128 * 512, N1, tid); }
    for (int u = blockIdx.x; u < nunits; u += gridDim.x) {
        const int g = u & 3, n2 = (u >> 2) & 127, seq = u >> 9;
        tr_commit(R2, pf, N1, tid);
        __syncthreads();
        { const int un = u + gridDim.x; if (un < nunits) { const int gn = un & 3, n2n = (un >> 2) & 127, seqn = un >> 9; tr_issue(pf, Fb + ((size_t)seqn * S + n2n) * 512 + gn * 128, (size_t)128 * 512, N1, tid); } }
        if (64 * wr <= N1) {
            f32x4 P1[2][4], P2[2][4];
            zero_acc(P1); mm_tile(P1, R0, R2, wr, wc, fr, fq, ksteps);
            zero_acc(P2); mm_tile(P2, R1, R2, wr, wc, fr, fq, ksteps);
#pragma unroll
            for (int mi = 0; mi < 2; ++mi) {
                const int k1 = 32 * wr + 16 * mi + fr;
                const float a = (float)(n2 * k1) * invS, cs = __builtin_amdgcn_cosf(a), sn = __builtin_amdgcn_sinf(a);
                const size_t rowoff = ((size_t)seq * S + (size_t)k1 * 128 + n2) * 512 + g * 128 + 64 * wc + 4 * fq;
                if (2 * k1 <= N1) {
#pragma unroll
                for (int ni = 0; ni < 4; ++ni) {
                    const f32x4 re = P1[mi][ni] * cs - P2[mi][ni] * sn, im = -(P2[mi][ni] * cs + P1[mi][ni] * sn);
                    u32x2 w; w.x = cvt_pk_bf16(re[0], re[1]); w.y = cvt_pk_bf16(re[2], re[3]); *(u32x2*)(APR + rowoff + 16 * ni) = w;
                    w.x = cvt_pk_bf16(im[0], im[1]); w.y = cvt_pk_bf16(im[2], im[3]); *(u32x2*)(API + rowoff + 16 * ni) = w;
                }
                }
            }
        }
        __syncthreads();
    }
}
__device__ __forceinline__ void phase_FB(const PRef& p, LAS unsigned char* lds, int h) {
    int tid_ = threadIdx.x; asm volatile("" : "+v"(tid_)); const int tid = tid_, wid = tid >> 6, lane = tid & 63, wr = wid >> 1, wc = wid & 1, fr = lane & 15, fq = lane >> 4;
    const int N1 = h ? 64 : 128, nseq = h ? 4 : 2, S = N1 * 128, nk = N1 / 2 - 1, ND = nseq * nk * 4, NSLOT = ND + nseq * 4;
    const float scale = h ? 0.0009765625f : 0.0006905339660024878f;
    unsigned char* db = (unsigned char*)p.out() + (size_t)h * DO_STRIDE;
    const bf16_t* APR = (const bf16_t*)(db + DO_APR); const bf16_t* API = (const bf16_t*)(db + DO_API);
    bf16_t* FR = (bf16_t*)(p.ws() + WS_HB + (size_t)h * HB_STRIDE + HB_F);
    LAS unsigned char* R0 = lds; LAS unsigned char* R1 = lds + TREG; LAS unsigned char* R2 = lds + 2 * TREG; LAS unsigned char* R3 = lds + 3 * TREG;
    fill_dft(R0, R1, 128, tid);
    __syncthreads();
    for (int sl = blockIdx.x; sl < NSLOT; sl += gridDim.x) {
        const int nit = (sl < ND) ? 1 : 2;
#pragma unroll 1
        for (int e = 0; e < nit; ++e) {
            int g, k1, seq; bool mirror;
            if (sl < ND) { g = sl & 3; const int t = sl >> 2; seq = t / nk; k1 = t - seq * nk + 1; mirror = true; }
            else { const int sidx = 2 * (sl - ND) + e; g = sidx & 3; k1 = ((sidx >> 2) & 1) ? N1 / 2 : 0; seq = sidx >> 3; mirror = false; }
            const size_t soff = ((size_t)seq * S + (size_t)k1 * 128) * 512 + g * 128;
            load_tr(R2, APR + soff, 512, 128, tid); load_tr(R3, API + soff, 512, 128, tid);
            __syncthreads();
            f32x4 aR[2][4], a3[2][4], a4[2][4];
            zero_acc(aR); mm_tile(aR, R0, R2, wr, wc, fr, fq, 4); mm_tile(aR, R1, R3, wr, wc, fr, fq, 4);
            zero_acc(a3); mm_tile(a3, R0, R3, wr, wc, fr, fq, 4);
            zero_acc(a4); mm_tile(a4, R1, R2, wr, wc, fr, fq, 4);
            __syncthreads();
#pragma unroll
            for (int mi = 0; mi < 2; ++mi)
#pragma unroll
                for (int ni = 0; ni < 4; ++ni) a3[mi][ni] = a3[mi][ni] - a4[mi][ni];
            store_acc_lds(R2, aR, wr, wc, fr, fq); store_acc_lds(R3, a3, wr, wc, fr, fq);
            __syncthreads();
            zero_acc(aR); mm_tile(aR, R2, R0, wr, wc, fr, fq, 4);
            zero_acc(a3); mm_tile(a3, R3, R1, wr, wc, fr, fq, 4);
#pragma unroll
            for (int mi = 0; mi < 2; ++mi) {
                const int k2 = 32 * wr + 16 * mi + fr;
                const size_t coloff = (size_t)g * 128 + 64 * wc + 4 * fq;
                const size_t row = (size_t)seq * S + k1 + (size_t)N1 * k2, mrow = (size_t)seq * S + (N1 - k1) + (size_t)N1 * (127 - k2);
#pragma unroll
                for (int ni = 0; ni < 4; ++ni) {
                    const f32x4 o = (aR[mi][ni] + a3[mi][ni]) * scale;
                    u32x2 w; w.x = cvt_pk_bf16(o[0], o[1]); w.y = cvt_pk_bf16(o[2], o[3]); *(u32x2*)(FR + row * 512 + coloff + 16 * ni) = w;
                    if (mirror) {
                        const f32x4 om = (aR[mi][ni] - a3[mi][ni]) * scale;
                        u32x2 wm; wm.x = cvt_pk_bf16(om[0], om[1]); wm.y = cvt_pk_bf16(om[2], om[3]); *(u32x2*)(FR + mrow * 512 + coloff + 16 * ni) = wm;
                    }
                }
            }
            __syncthreads();
        }
    }
}

struct Ctx { unsigned char* ws; unsigned char* dout; bf16_t* XB; float* RS; float* SS; const bf16_t* Wl; };
__device__ __forceinline__ void st_ffn_in(const Ctx& c, LAS unsigned char* lds, int hh, int second) {
    EpiSwiGLU E; E.U = hh ? (bf16_t*)(c.dout + DO_U1) : (bf16_t*)(c.ws + WS_U0); E.rs = c.RS + hh * HT;
    run_gemm(lds, c.XB + (size_t)hh * HT * 1024, c.Wl + (second ? WO_F2I : WO_F1I), HT, 5632, 1024, E);
}
__device__ __forceinline__ void st_ffn_out(const Ctx& c, LAS unsigned char* lds, int hh, int second) {
    EpiRes E; E.X = c.XB + (size_t)hh * HT * 1024; E.ss = c.SS + (size_t)hh * HT * 16; E.scale = 0.5f;
    run_gemm(lds, hh ? (const bf16_t*)(c.dout + DO_U1) : (const bf16_t*)(c.ws + WS_U0), c.Wl + (second ? WO_F2O : WO_F1O), HT, 1024, 2816, E);
}
__device__ __forceinline__ void st_rowstat(const Ctx& c, int hh) { rowstat_slots(c.SS + (size_t)hh * HT * 16, c.RS + hh * HT, HT); }
__device__ __forceinline__ void st_win(const Ctx& c, LAS unsigned char* lds, int hh) {
    EpiWin E; E.base = (bf16_t*)(c.ws + WS_HB + (size_t)hh * HB_STRIDE); E.rope = (const float*)(c.ws + WS_ROPE); E.rs = c.RS + hh * HT; E.smask = hh ? 8191 : 16383;
    run_gemm(lds, c.XB + (size_t)hh * HT * 1024, c.Wl + WO_WIN, HT, 2560, 1024, E);
}
__device__ __forceinline__ void st_retfou(const Ctx& c, LAS unsigned char* lds, int hh) {
    unsigned char* hb = c.ws + WS_HB + (size_t)hh * HB_STRIDE; unsigned char* db = c.dout + (size_t)hh * DO_STRIDE;
#pragma unroll 1
    for (int t = 0; t < 2; ++t) {
        EpiBf E; E.O = t ? (bf16_t*)(db + DO_FOU) : (bf16_t*)(hb + HB_RET);
        run_gemm(lds, (const bf16_t*)(hb + (t ? HB_F : HB_Q)), c.Wl + (t ? WO_FFT : WO_RET), HT, 1024, 512, E);
    }
}
__device__ __forceinline__ void st_gates(const Ctx& c, LAS unsigned char* lds, int hh) {
    unsigned char* hb = c.ws + WS_HB + (size_t)hh * HB_STRIDE; unsigned char* db = c.dout + (size_t)hh * DO_STRIDE;
    EpiGates E; E.RET = (const bf16_t*)(hb + HB_RET); E.FOU = (const bf16_t*)(db + DO_FOU); E.MRG = (bf16_t*)(db + DO_MRG); E.rs = c.RS + hh * HT;
    run_gemm(lds, c.XB + (size_t)hh * HT * 1024, c.Wl + WO_WIN + 2560ull * 1024, HT, 2048, 1024, E);
}
__device__ __forceinline__ void st_mix(const Ctx& c, LAS unsigned char* lds, int hh) {
    EpiRes E; E.X = c.XB + (size_t)hh * HT * 1024; E.ss = c.SS + (size_t)hh * HT * 16; E.scale = 1.0f;
    run_gemm(lds, (const bf16_t*)(c.dout + (size_t)hh * DO_STRIDE + DO_MRG), c.Wl + WO_MIX, HT, 1024, 1024, E);
}
__device__ __forceinline__ void run_phase(const PRef& p, LAS unsigned char* lds, int ph) {
    Ctx c; c.ws = p.ws(); c.dout = (unsigned char*)p.out(); c.XB = (bf16_t*)(c.ws + WS_XB); c.RS = (float*)(c.ws + WS_RS); c.SS = (float*)(c.ws + WS_SS); c.Wl = (const bf16_t*)(c.ws + WS_W);
    if (ph == 0) {
        phase_prep(p, lds, 0, 7);
        rows_init(p.in(0), c.XB, c.RS, HT); rows_init(p.in(1), c.XB + (size_t)HT * 1024, c.RS + HT, HT);
        return;
    }
    if (ph == NPHASES - 1) { final_norm(c.XB, p.in(15), p.out(), 2 * HT); return; }
    const int q = ph - 1, l = q / 14, s = q % 14;
    switch (s) {
    case 0:  st_ffn_in(c, lds, 0, 0); if (l > 0) st_rowstat(c, 1); break;
    case 1:  st_ffn_out(c, lds, 0, 0); st_ffn_in(c, lds, 1, 0); break;
    case 2:  st_ffn_out(c, lds, 1, 0); st_rowstat(c, 0); if (l > 0) phase_prep(p, lds, l, 2); break;
    case 3:  st_win(c, lds, 0); st_rowstat(c, 1); break;
    case 4:  st_win(c, lds, 1); phase_RA(p, lds, l, 0); phase_FA(p, lds, 0); break;
    case 5:  phase_RA(p, lds, l, 1); phase_FA(p, lds, 1); phase_RB(p, l, 0); phase_FB(p, lds, 0); break;
    case 6:  phase_RC(p, lds, l, 0); phase_RB(p, l, 1); phase_FB(p, lds, 1); break;
    case 7:  st_retfou(c, lds, 0); phase_RC(p, lds, l, 1); break;
    case 8:  st_gates(c, lds, 0); st_retfou(c, lds, 1); break;
    case 9:  st_mix(c, lds, 0); st_gates(c, lds, 1); break;
    case 10: st_mix(c, lds, 1); st_rowstat(c, 0); break;
    case 11: st_ffn_in(c, lds, 0, 1); st_rowstat(c, 1); if (l == 0) phase_prep(p, lds, l + 1, 1); break;
    case 12: st_ffn_out(c, lds, 0, 1); st_ffn_in(c, lds, 1, 1); break;
    default: st_ffn_out(c, lds, 1, 1); if (l == 0) st_rowstat(c, 0); break;
    }
}

__global__ void __launch_bounds__(512, 2) fwd_megakernel(Params p0) {
    extern __shared__ __attribute__((aligned(16))) unsigned char shm[];
    LAS unsigned char* lds = (LAS unsigned char*)shm;
    volatile LAS unsigned* st = (volatile LAS unsigned*)(lds + LDS_TILES);
    if (threadIdx.x == 0) { st[0] = 0u; st[1] = 0u; }
    __syncthreads();
    (void)xcd_barrier_post((unsigned*)(p0.ws + WS_CTL), st);
    const int ph_lo = p0.ph_lo, ph_hi = p0.ph_hi;
    for (int ph = ph_lo; ph < ph_hi; ++ph) {
        PRef p; p.kp = (const AS4 Params*)__builtin_amdgcn_kernarg_segment_ptr();
        asm volatile("" : "+s"(p.kp));
        run_phase(p, lds, ph);
        if (ph + 1 < ph_hi) {
            if (ph == ph_lo) { __threadfence(); cg::this_grid().sync(); }
            else { XcdBarrier xb; xb.bar = (unsigned*)(p.ws() + WS_CTL); xb.x = xb_xcc_id(); xb.st = (volatile LAS unsigned*)(lds + LDS_TILES); xcd_barrier(xb);
#ifdef DBLBAR
                xcd_barrier(xb);
#endif
            }
        }
    }
}

extern "C" void kernel_launch(void* const* d_in, const int* in_sizes, int n_in, void* d_out, int out_size, void* d_ws, size_t ws_size, hipStream_t stream) {
    static int grid = 0;
    if (grid == 0) {
        if (n_in != 16 || out_size != 2 * HT * 1024 || ws_size < WS_END) { fprintf(stderr, "kernel_launch: unexpected shapes (n_in %d out %d ws %zu)\n", n_in, out_size, ws_size); grid = -1; return; }
        int dev = 0, cus = 0, per_cu = 0;
        if (hipGetDevice(&dev) != hipSuccess || hipDeviceGetAttribute(&cus, hipDeviceAttributeMultiprocessorCount, dev) != hipSuccess) { grid = -1; return; }
        if (hipFuncSetAttribute((const void*)fwd_megakernel, hipFuncAttributeMaxDynamicSharedMemorySize, LDS_BYTES) != hipSuccess) { fprintf(stderr, "kernel_launch: hipFuncSetAttribute failed\n"); grid = -1; return; }
        if (hipOccupancyMaxActiveBlocksPerMultiprocessor(&per_cu, (const void*)fwd_megakernel, 512, LDS_BYTES) != hipSuccess || per_cu < 1) { fprintf(stderr, "kernel_launch: occupancy query says %d\n", per_cu); per_cu = 1; }
        (void)hipGetLastError();
        grid = cus;
    }
    if (grid < 0) return;
    if (hipMemsetAsync((unsigned char*)d_ws + WS_CTL, 0, XCD_BAR_WORDS * sizeof(unsigned), stream) != hipSuccess) return;
    Params p{};
    for (int i = 0; i < 16; ++i) p.in[i] = (const float*)d_in[i];
    p.out = (float*)d_out; p.ws = (unsigned char*)d_ws;
#if MK_ONE_LAUNCH
    p.ph_lo = 0; p.ph_hi = NPHASES;
    void* args[] = {&p};
    hipError_t e = hipLaunchCooperativeKernel((const void*)fwd_megakernel, dim3(grid), dim3(512), args, LDS_BYTES, stream);
    if (e != hipSuccess) fprintf(stderr, "cooperative launch failed: %s (grid %d)\n", hipGetErrorString(e), grid);
#else
    for (int ph = 0; ph < NPHASES; ++ph) {
        p.ph_lo = ph; p.ph_hi = ph + 1;
        hipLaunchKernelGGL(fwd_megakernel, dim3(grid), dim3(512), LDS_BYTES, stream, p);
    }
#endif
}
```

```cpp
#include <hip/hip_runtime.h>
#include <hip/hip_cooperative_groups.h>
#include <cstdio>
#include <cstdint>
namespace cg = cooperative_groups;
#ifndef MK_ONE_LAUNCH
#define MK_ONE_LAUNCH 1
#endif
#define SKIP_FFT 0
#define OUT_SCALE 1.0f
#ifndef GEMM_ALIGN
#define GEMM_ALIGN true
#endif
#ifndef GEMM_SP2
#define GEMM_SP2 true
#endif
#ifndef RES_ALIGN
#define RES_ALIGN true
#endif
#ifndef SWI_ALIGN
#define SWI_ALIGN true
#endif
#ifndef WGM_SET
#define WGM_SET 4
#endif
#ifndef NXCD_SET
#define NXCD_SET 8
#endif
namespace pg8 {
#define PG8_LAS __attribute__((address_space(3)))
typedef unsigned short bf16_t;
typedef short bf16x8 __attribute__((ext_vector_type(8)));
typedef float f32x4 __attribute__((ext_vector_type(4)));
typedef unsigned u32x4 __attribute__((ext_vector_type(4)));
constexpr int BM = 256, BK = 64, HALF = 128, HTB = HALF * BK * 2  , STAGE_BYTES = 8 * HTB, NXCD = NXCD_SET, WGM = WGM_SET;

__host__ __device__ __forceinline__ int lds_byte(int r, int c) { const int st = (r >> 4) * 2 + (c >> 5), rr = r & 15, cc = c & 31, ob = rr * 64 + cc * 2; return st * 1024 + (ob ^ (((ob >> 9) & 1) << 5)); }
__host__ __device__ __forceinline__ void stage_rc(int b, int& R, int& C) { const int st = b / 1024, sb = b % 1024, swz = sb ^ (((sb >> 9) & 1) << 5); R = (st >> 1) * 16 + swz / 64; C = (st & 1) * 32 + (swz % 64) / 2; }
__host__ __device__ __forceinline__ int perm32(int rho) { const int n = rho >> 4, i = rho & 15; return 8 * (i >> 2) + 4 * n + (i & 3); }

struct Unit { int pm, pn; };
struct Gemm { const bf16_t* A; const bf16_t* Bt; int M, N, K; };

struct StaticOrder {
    int nM, nN, nwg, G, c;
    __host__ __device__ void init(int M, int N, int G_, int c_) { nM = M / BM; nN = N / BM; nwg = nM * nN; G = G_; c = c_; }
    __host__ __device__ bool next(int i, Unit& u) const {
        const long L = (long)i * G + c; if (L >= nwg) return false;
        int wgid = (int)L; { const int q = nwg / NXCD, r = nwg % NXCD, xcd = wgid % NXCD, off = wgid / NXCD; wgid = (xcd < r ? xcd * (q + 1) : r * (q + 1) + (xcd - r) * q) + off; }
        const int nig = WGM * nN, gid = wgid / nig, fm = gid * WGM, gsz = (nM - fm) < WGM ? (nM - fm) : WGM;
        u.pm = fm + ((wgid % nig) % gsz); u.pn = (wgid % nig) / gsz; return true;
    }
    __device__ __forceinline__ void a_ready(const Unit&) const {}
    __device__ __forceinline__ void done(const Unit&) const {}
};
typedef __bf16 bf16v2_t __attribute__((ext_vector_type(2)));
typedef float f32v2_t __attribute__((ext_vector_type(2)));
__device__ __forceinline__ unsigned cvt_pk_bf16(float lo, float hi) { const f32v2_t v = {lo, hi}; const bf16v2_t r = __builtin_convertvector(v, bf16v2_t); return __builtin_bit_cast(unsigned, r); }
template <class Epi, class Sched, bool ALIGN_EPI = false, bool SP2 = false>
__device__ __forceinline__ void gemm_phase(PG8_LAS unsigned char* lds, const Gemm g, const Sched& S, const Epi& E) {
    int tid_ = threadIdx.x; asm volatile("" : "+v"(tid_)); const int tid = tid_, wid = __builtin_amdgcn_readfirstlane(tid >> 6), lane = tid & 63, wr = wid >> 2, wc = wid & 3, fr = lane & 15, fq = lane >> 4;
    const int K = g.K, nt = K / BK;
    unsigned voffA[2], voffB[2];
#pragma unroll
    for (int i = 0; i < 2; ++i) { int R, C; stage_rc(tid * 16 + i * 8192, R, C); const int Rb = Epi::PERM ? ((R & ~31) + perm32(R & 31)) : R;
        voffA[i] = (unsigned)(R * K + C) * 2u; voffB[i] = (unsigned)(Rb * K + C) * 2u; }
    const size_t kstep = (size_t)(BK * 2);
    const size_t hstep = (size_t)HALF * K * 2;
    const size_t tstep = 2 * hstep;
    const unsigned ldsw = (unsigned)wid * 1024u;
    const int aoff = lds_byte(wr * 64 + fr, fq * 8), boff = lds_byte(wc * 32 + fr, fq * 8);
#define PG8_SA(b, h) (((b) * 2 + (h)) * HTB)
#define PG8_SB(b, h) ((4 + (b) * 2 + (h)) * HTB)
#define PG8_STAGE(bufoff, gbase, voff) do { _Pragma("unroll") for (int _i = 0; _i < 2; ++_i) \
        __builtin_amdgcn_global_load_lds((const unsigned*)((const char*)(gbase) + (voff)[_i]), (PG8_LAS unsigned*)(lds + (bufoff) + ldsw + _i * 8192), 16, 0, 0); } while (0)
#define PG8_LDA(dst, b, h) do { _Pragma("unroll") for (int m = 0; m < 4; ++m) _Pragma("unroll") for (int k = 0; k < 2; ++k) dst[m][k] = *(const PG8_LAS bf16x8*)(lds + PG8_SA(b, h) + aoff + m * 2048 + k * 1024); } while (0)
#define PG8_LDB(dst, b, h) do { _Pragma("unroll") for (int n = 0; n < 2; ++n) _Pragma("unroll") for (int k = 0; k < 2; ++k) dst[n][k] = *(const PG8_LAS bf16x8*)(lds + PG8_SB(b, h) + boff + n * 2048 + k * 1024); } while (0)
#define PG8_MMA(ai, bj, At, Bt) do { __builtin_amdgcn_s_setprio(1); _Pragma("unroll") for (int m = 0; m < 4; ++m) _Pragma("unroll") for (int n = 0; n < 2; ++n) _Pragma("unroll") for (int k = 0; k < 2; ++k) \
        acc[ai][bj][m][n] = __builtin_amdgcn_mfma_f32_16x16x32_bf16(Bt[n][k], At[m][k], acc[ai][bj][m][n], 0, 0, 0); __builtin_amdgcn_s_setprio(0); } while (0)
#define PG8_WAIT_V(n) asm volatile("s_waitcnt vmcnt(" #n ")" ::: "memory")
#define PG8_WAIT_L(n) asm volatile("s_waitcnt lgkmcnt(" #n ")" ::: "memory")
#define PG8_BAR __builtin_amdgcn_s_barrier()
#define PG8_SCHED __builtin_amdgcn_sched_barrier(0)
    Unit cur, nxt; int ui = 0;
    if (!S.next(0, cur)) return;
    f32x4 acc[2][2][4][2];
#pragma unroll
    for (int a = 0; a < 2; ++a)
#pragma unroll
        for (int b = 0; b < 2; ++b)
#pragma unroll
            for (int m = 0; m < 4; ++m)
#pragma unroll
                for (int n = 0; n < 2; ++n) acc[a][b][m][n] = (f32x4){0.f, 0.f, 0.f, 0.f};
    bf16x8 At[4][2], B0[2][2], B1[2][2];
    const char* cA = (const char*)g.A + (size_t)cur.pm * tstep; const char* cB = (const char*)g.Bt + (size_t)cur.pn * tstep;
    S.a_ready(cur);
    if constexpr (SP2) {
        PG8_STAGE(PG8_SB(0, 0), cB, voffB); PG8_STAGE(PG8_SB(0, 1), cB + hstep, voffB); PG8_STAGE(PG8_SA(0, 0), cA, voffA); PG8_STAGE(PG8_SA(0, 1), cA + hstep, voffA);
        if (wr == 1) PG8_BAR;
        PG8_WAIT_V(2); PG8_BAR;
        PG8_STAGE(PG8_SB(1, 0), cB + kstep, voffB); PG8_STAGE(PG8_SA(1, 0), cA + kstep, voffA); PG8_STAGE(PG8_SB(1, 1), cB + hstep + kstep, voffB);
        PG8_WAIT_V(6); PG8_BAR;
    } else {
        PG8_STAGE(PG8_SB(0, 0), cB, voffB); PG8_STAGE(PG8_SA(0, 0), cA, voffA); PG8_STAGE(PG8_SB(0, 1), cB + hstep, voffB); PG8_STAGE(PG8_SA(0, 1), cA + hstep, voffA);
        if (wr == 1) PG8_BAR;
        PG8_WAIT_V(4); PG8_BAR;
        PG8_STAGE(PG8_SB(1, 0), cB + kstep, voffB); PG8_STAGE(PG8_SA(1, 0), cA + kstep, voffA); PG8_STAGE(PG8_SB(1, 1), cB + hstep + kstep, voffB);
        PG8_WAIT_V(6); PG8_BAR;
    }
    for (;;) {
        const bool has_next = S.next(ui + 1, nxt);
        const char* nA = has_next ? (const char*)g.A + (size_t)nxt.pm * tstep : cA; const char* nB = has_next ? (const char*)g.Bt + (size_t)nxt.pn * tstep : cB;
        for (int t = 0; t < nt; t += 2) {
            const bool last = (t == nt - 2);
            const char* a1 = cA + (size_t)(t + 1) * kstep;
            const char* a2 = last ? nA : cA + (size_t)(t + 2) * kstep; const char* b2 = last ? nB : cB + (size_t)(t + 2) * kstep;
            const char* a3 = a2 + kstep; const char* b3 = b2 + kstep;
            if (last && has_next) S.a_ready(nxt);
            if constexpr (SP2) {
            PG8_LDB(B0, 0, 0); PG8_LDB(B1, 0, 1); PG8_SCHED; PG8_LDA(At, 0, 0); PG8_STAGE(PG8_SA(1, 1), a1 + hstep, voffA);
            PG8_WAIT_V(8); PG8_WAIT_L(0); PG8_BAR; PG8_MMA(0, 0, At, B0); PG8_MMA(0, 1, At, B1); PG8_BAR; PG8_SCHED;
            PG8_LDA(At, 0, 1); PG8_STAGE(PG8_SB(0, 0), b2, voffB); PG8_STAGE(PG8_SB(0, 1), b2 + hstep, voffB); PG8_STAGE(PG8_SA(0, 0), a2, voffA);
            PG8_WAIT_V(8); PG8_WAIT_L(0); PG8_BAR; PG8_MMA(1, 0, At, B0); PG8_MMA(1, 1, At, B1); PG8_BAR; PG8_SCHED;
            PG8_LDB(B0, 1, 0); PG8_LDB(B1, 1, 1); PG8_SCHED; PG8_LDA(At, 1, 0); PG8_STAGE(PG8_SA(0, 1), a2 + hstep, voffA);
            PG8_WAIT_V(8); PG8_WAIT_L(0); PG8_BAR; PG8_MMA(0, 0, At, B0); PG8_MMA(0, 1, At, B1); PG8_BAR; PG8_SCHED;
            PG8_LDA(At, 1, 1); PG8_STAGE(PG8_SB(1, 0), b3, voffB); PG8_STAGE(PG8_SB(1, 1), b3 + hstep, voffB); PG8_STAGE(PG8_SA(1, 0), a3, voffA);
            PG8_WAIT_V(8); PG8_WAIT_L(0); PG8_BAR; PG8_MMA(1, 0, At, B0); PG8_MMA(1, 1, At, B1); PG8_BAR; PG8_SCHED;
            } else {
            PG8_LDB(B0, 0, 0); PG8_SCHED; PG8_LDA(At, 0, 0); PG8_STAGE(PG8_SA(1, 1), a1 + hstep, voffA);
            PG8_WAIT_L(8); PG8_BAR; PG8_WAIT_L(0); PG8_MMA(0, 0, At, B0); PG8_BAR; PG8_SCHED;
            PG8_LDB(B1, 0, 1); PG8_STAGE(PG8_SB(0, 0), b2, voffB);
            PG8_BAR; PG8_WAIT_L(0); PG8_MMA(0, 1, At, B1); PG8_BAR;
            PG8_LDA(At, 0, 1); PG8_STAGE(PG8_SA(0, 0), a2, voffA);
            PG8_BAR; PG8_WAIT_L(0); PG8_MMA(1, 0, At, B0); PG8_BAR; PG8_SCHED;
            PG8_STAGE(PG8_SB(0, 1), b2 + hstep, voffB);
            PG8_WAIT_V(6); PG8_BAR; PG8_MMA(1, 1, At, B1); PG8_BAR;
            PG8_LDB(B0, 1, 0); PG8_SCHED; PG8_LDA(At, 1, 0); PG8_STAGE(PG8_SA(0, 1), a2 + hstep, voffA);
            PG8_WAIT_L(8); PG8_BAR; PG8_WAIT_L(0); PG8_MMA(0, 0, At, B0); PG8_BAR; PG8_SCHED;
            PG8_LDB(B1, 1, 1); PG8_STAGE(PG8_SB(1, 0), b3, voffB);
            PG8_BAR; PG8_WAIT_L(0); PG8_MMA(0, 1, At, B1); PG8_BAR;
            PG8_LDA(At, 1, 1); PG8_STAGE(PG8_SA(1, 0), a3, voffA);
            PG8_BAR; PG8_WAIT_L(0); PG8_MMA(1, 0, At, B0); PG8_BAR; PG8_SCHED;
            PG8_STAGE(PG8_SB(1, 1), b3 + hstep, voffB);
            PG8_WAIT_V(6); PG8_BAR; PG8_MMA(1, 1, At, B1); PG8_BAR;
            }
        }
        if constexpr (ALIGN_EPI) { if (wr == 0) PG8_BAR; }
        if constexpr (!Epi::AFTER_DRAIN) { E(acc, cur, wr, wc, fr, fq); S.done(cur); }
        if (!has_next) break;
#pragma unroll
        for (int a = 0; a < 2; ++a)
#pragma unroll
            for (int b = 0; b < 2; ++b)
#pragma unroll
                for (int m = 0; m < 4; ++m)
#pragma unroll
                    for (int n = 0; n < 2; ++n) acc[a][b][m][n] = (f32x4){0.f, 0.f, 0.f, 0.f};
        cur = nxt; cA = nA; cB = nB; ++ui;
        if constexpr (ALIGN_EPI) { if (wr == 1) PG8_BAR; }
    }
    PG8_WAIT_V(0);
    if constexpr (!ALIGN_EPI) { if (wr == 0) PG8_BAR; }
    PG8_BAR;
    if constexpr (Epi::AFTER_DRAIN) { E.fused(acc, cur, wr, wc, fr, fq, lds, wid, lane); S.done(cur); }
#undef PG8_SA
#undef PG8_SB
#undef PG8_STAGE
#undef PG8_LDA
#undef PG8_LDB
#undef PG8_MMA
#undef PG8_WAIT_V
#undef PG8_WAIT_L
#undef PG8_BAR
#undef PG8_SCHED
}
}
#define XB_TMO      128
#define XB_XCNT(j)  (256  + 64 * (j))
#define XB_XSUB(j)  (1280 + 64 * (j))
#define XB_XGEN(j)  (2304 + 64 * (j))
#define XB_TOP      3328
#define XB_TOPGEN   3392
#define XCD_BAR_WORDS 3456
#define XB_SPIN_CAP (1u << 18)
#define LAS __attribute__((address_space(3)))

__device__ __forceinline__ unsigned xb_ld(unsigned* p)              { return __hip_atomic_load(p, __ATOMIC_RELAXED, __HIP_MEMORY_SCOPE_AGENT); }
__device__ __forceinline__ unsigned xb_add(unsigned* p, unsigned v) { return __hip_atomic_fetch_add(p, v, __ATOMIC_RELAXED, __HIP_MEMORY_SCOPE_AGENT); }
__device__ __forceinline__ unsigned xb_xcc_id() { return (unsigned)__builtin_amdgcn_s_getreg((3 << 11) | 20) & 0xFu; }
#define XB_SPIN(cond, bar) do { unsigned _sp = 0; while (cond) { __builtin_amdgcn_s_sleep(1); \
    if ((++_sp & 255u) == 0u) { if (xb_ld(&(bar)[XB_TMO])) break; if (_sp > XB_SPIN_CAP) { atomicAdd(&(bar)[XB_TMO], 1u); break; } } } } while (0)

struct XcdBarrier {
    unsigned* bar; unsigned x;
    volatile LAS unsigned* st;
};

__device__ __forceinline__ XcdBarrier xcd_barrier_post(unsigned* bar, volatile LAS unsigned* st) {
    XcdBarrier b; b.bar = bar; b.x = xb_xcc_id(); b.st = st;
    if (threadIdx.x == 0) (void)xb_add(&bar[XB_XCNT(b.x)], 1u);
    return b;
}
__device__ __forceinline__ void xcd_barrier_complete(unsigned* bar, unsigned x, unsigned& nloc, unsigned& nx) {
    const unsigned G = gridDim.x * gridDim.y * gridDim.z;
    unsigned sum, cnt, mine, sp = 0u;
    for (;;) {
        sum = 0u; cnt = 0u; mine = 0u;
#pragma unroll
        for (unsigned j = 0; j < 16; ++j) { const unsigned c = xb_ld(&bar[XB_XCNT(j)]); sum += c; cnt += (c > 0u) ? 1u : 0u; mine = (j == x) ? c : mine; }
        if (sum == G) break;
        __builtin_amdgcn_s_sleep(1);
        if ((++sp & 255u) == 0u) { if (xb_ld(&bar[XB_TMO])) break; if (sp > XB_SPIN_CAP) { atomicAdd(&bar[XB_TMO], 1u); break; } }
    }
    nloc = mine > 0u ? mine : 1u; nx = cnt > 0u ? cnt : 1u;
}

__device__ __forceinline__ void xcd_barrier(const XcdBarrier& b) {
    asm volatile("s_waitcnt vmcnt(0)" ::: "memory");
    __syncthreads();
    if (threadIdx.x == 0) {
        unsigned* bar = b.bar;
        __builtin_amdgcn_s_waitcnt(0);
        unsigned nloc = b.st[0], nx = b.st[1];
        if (nloc == 0u) { xcd_barrier_complete(bar, b.x, nloc, nx); b.st[0] = nloc; b.st[1] = nx; }
        const unsigned old = xb_add(&bar[XB_XSUB(b.x)], 1u);
        const unsigned gen = old / nloc;
        if (old + 1u == (gen + 1u) * nloc) {
            __builtin_amdgcn_fence(__ATOMIC_RELEASE, "agent");
            asm volatile("s_waitcnt vmcnt(0)" ::: "memory");
            const unsigned og = xb_add(&bar[XB_TOP], 1u);
            const unsigned tg = og / nx;
            if (og + 1u == (tg + 1u) * nx) xb_add(&bar[XB_TOPGEN], 1u);
            else XB_SPIN(xb_ld(&bar[XB_TOPGEN]) == tg, bar);
            __builtin_amdgcn_fence(__ATOMIC_ACQUIRE, "agent");
            xb_add(&bar[XB_XGEN(b.x)], 1u);
            asm volatile("s_waitcnt vmcnt(0)" ::: "memory");
        } else {
            XB_SPIN(xb_ld(&bar[XB_XGEN(b.x)]) == gen, bar);
            __builtin_amdgcn_fence(__ATOMIC_ACQUIRE, "agent");
            asm volatile("s_waitcnt vmcnt(0)" ::: "memory");
        }
    }
    __syncthreads();
}


using pg8::bf16_t; using pg8::bf16x8; using pg8::f32x4; using pg8::u32x4; using pg8::cvt_pk_bf16;
typedef unsigned u32x2 __attribute__((ext_vector_type(2)));
typedef float f32x2v __attribute__((ext_vector_type(2)));

constexpr int HT = 32768;
constexpr size_t MiB = 1ull << 20;
constexpr size_t WS_W = 0, WS_ROPE = 46 * MiB, WS_XB = 54 * MiB, WS_HB = 182 * MiB, HB_STRIDE = 160 * MiB, WS_U0 = 182 * MiB, WS_CTL = 502 * MiB, WS_RS = 503 * MiB, WS_SS = 504 * MiB, WS_END = 508 * MiB;
constexpr size_t HB_Q = 0, HB_K = 32 * MiB, HB_V = 64 * MiB, HB_SG = 96 * MiB, HB_F = 128 * MiB, HB_RET = HB_K;
constexpr size_t DO_STRIDE = 128 * MiB, DO_KVF = 0, DO_KVB = 32 * MiB, DO_APR = 64 * MiB, DO_API = 96 * MiB, DO_MRG = 0, DO_FOU = 64 * MiB, DO_U1 = 0;
constexpr size_t WO_F1I = 0, WO_F1O = WO_F1I + 5632ull * 1024, WO_WIN = WO_F1O + 1024ull * 2816, WO_RET = WO_WIN + 4608ull * 1024, WO_FFT = WO_RET + 1024ull * 512,
    WO_MIX = WO_FFT + 1024ull * 512, WO_F2I = WO_MIX + 1024ull * 1024, WO_F2O = WO_F2I + 5632ull * 1024, WO_LAYER = WO_F2O + 1024ull * 2816;
constexpr int LDS_TILES = 4 * 34816;
constexpr int LDS_ST = LDS_TILES + 16;
constexpr int LDS_BYTES = LDS_ST + 2048;
constexpr int TP = 272, TREG = 128 * TP;
constexpr float LOG2E = 1.4426950408889634f;
constexpr int NPHASES = 30;

struct Params { const float* in[16]; float* out; unsigned char* ws; int ph_lo, ph_hi; };
#define AS4 __attribute__((address_space(4)))
struct PRef {
    const AS4 Params* kp;
    __device__ __forceinline__ const float* in(int i) const { return kp->in[i]; }
    __device__ __forceinline__ float* out() const { return kp->out; }
    __device__ __forceinline__ unsigned char* ws() const { return kp->ws; }
};

__device__ __forceinline__ float wave_sum(float v) {
#pragma unroll
    for (int o = 1; o < 64; o <<= 1) v += __shfl_xor(v, o);
    return v;
}
__device__ __forceinline__ float silu_f(float x) { return x * __builtin_amdgcn_rcpf(1.0f + __builtin_amdgcn_exp2f(-x * LOG2E)); }
__device__ __forceinline__ float sigm_f(float x) { return __builtin_amdgcn_rcpf(1.0f + __builtin_amdgcn_exp2f(-x * LOG2E)); }
__device__ __forceinline__ float bflo(unsigned w) { return __uint_as_float(w << 16); }
__device__ __forceinline__ float bfhi(unsigned w) { return __uint_as_float(w & 0xffff0000u); }
#define LDS_WAIT() asm volatile("s_waitcnt lgkmcnt(0)" ::: "memory")

__device__ __forceinline__ float sumsq8(const u32x4 v);
struct EpiSwiGLU {
    static constexpr bool PERM = true, AFTER_DRAIN = false;
    bf16_t* U; const float* rs;
    __device__ __forceinline__ void operator()(const f32x4 (&acc)[2][2][4][2], const pg8::Unit& u, int wr, int wc, int fr, int fq) const {
        const int row0 = u.pm * 256 + wr * 64 + fr, col0 = u.pn * 128 + wc * 32 + 8 * fq;
        float rr[2][4];
#pragma unroll
        for (int ai = 0; ai < 2; ++ai)
#pragma unroll
            for (int m = 0; m < 4; ++m) rr[ai][m] = rs[row0 + ai * 128 + m * 16];
#pragma unroll
        for (int ai = 0; ai < 2; ++ai)
#pragma unroll
            for (int m = 0; m < 4; ++m) {
                bf16_t* p = U + (size_t)(row0 + ai * 128 + m * 16) * 2816 + col0;
                const float r = rr[ai][m];
                const f32x4 a0 = acc[ai][0][m][0] * r, a1 = acc[ai][0][m][1] * r, b0 = acc[ai][1][m][0] * r, b1 = acc[ai][1][m][1] * r;
                u32x4 w;
                w.x = cvt_pk_bf16(silu_f(a0[0]) * b0[0], silu_f(a0[1]) * b0[1]); w.y = cvt_pk_bf16(silu_f(a0[2]) * b0[2], silu_f(a0[3]) * b0[3]);
                w.z = cvt_pk_bf16(silu_f(a1[0]) * b1[0], silu_f(a1[1]) * b1[1]); w.w = cvt_pk_bf16(silu_f(a1[2]) * b1[2], silu_f(a1[3]) * b1[3]);
                *(u32x4*)p = w;
            }
    }
};
struct EpiRes {
    static constexpr bool PERM = true, AFTER_DRAIN = false;
    bf16_t* X; float* ss; float scale;
    __device__ __forceinline__ void operator()(const f32x4 (&acc)[2][2][4][2], const pg8::Unit& u, int wr, int wc, int fr, int fq) const {
        const int row0 = u.pm * 256 + wr * 64 + fr, col0 = u.pn * 256 + wc * 32 + 8 * fq;
#pragma unroll
        for (int ai = 0; ai < 2; ++ai) {
            u32x4 xv[4][2];
#pragma unroll
            for (int m = 0; m < 4; ++m)
#pragma unroll
                for (int bj = 0; bj < 2; ++bj) xv[m][bj] = *(const u32x4*)(X + (size_t)(row0 + ai * 128 + m * 16) * 1024 + col0 + bj * 128);
#pragma unroll
            for (int m = 0; m < 4; ++m) {
                float q = 0.f;
#pragma unroll
                for (int bj = 0; bj < 2; ++bj) {
                    const f32x4 v0 = acc[ai][bj][m][0] * scale, v1 = acc[ai][bj][m][1] * scale; const u32x4 x = xv[m][bj];
                    u32x4 w;
                    w.x = cvt_pk_bf16(bflo(x.x) + v0[0], bfhi(x.x) + v0[1]); w.y = cvt_pk_bf16(bflo(x.y) + v0[2], bfhi(x.y) + v0[3]);
                    w.z = cvt_pk_bf16(bflo(x.z) + v1[0], bfhi(x.z) + v1[1]); w.w = cvt_pk_bf16(bflo(x.w) + v1[2], bfhi(x.w) + v1[3]);
                    *(u32x4*)(X + (size_t)(row0 + ai * 128 + m * 16) * 1024 + col0 + bj * 128) = w;
                    q += sumsq8(w);
                }
                q += __shfl_xor(q, 16); q += __shfl_xor(q, 32);
                if (fq == 0) ss[(size_t)(row0 + ai * 128 + m * 16) * 16 + u.pn * 4 + wc] = q;
            }
            asm volatile("" ::: "memory");
        }
    }
};
struct EpiWin {
    static constexpr bool PERM = true, AFTER_DRAIN = false;
    bf16_t* base; const float* rope; const float* rs; int smask;
    __device__ __forceinline__ void operator()(const f32x4 (&acc)[2][2][4][2], const pg8::Unit& u, int wr, int wc, int fr, int fq) const {
        const int pn = u.pn, row0 = u.pm * 256 + wr * 64 + fr;
        if (pn < 4) {
            bf16_t* dstb = base + (size_t)(pn >> 1) * ((size_t)HT * 512);
            const float sc = (pn >> 1) ? 0.08838834764831845f : 1.0f;
            const int head = 2 * (pn & 1) + (wc >> 1), i0 = (wc & 1) * 32 + 8 * fq;
#pragma unroll
            for (int ai = 0; ai < 2; ++ai)
#pragma unroll
                for (int m = 0; m < 4; ++m) {
                    const int row = row0 + ai * 128 + m * 16, pos = row & smask;
                    const f32x4* rp = (const f32x4*)(rope + ((size_t)pos * 64 + i0) * 2);
                    const f32x4 t0 = rp[0], t1 = rp[1], t2 = rp[2], t3 = rp[3];
                    const float scr_ = sc * rs[row];
                    const f32x4 xa = acc[ai][0][m][0] * scr_, xb = acc[ai][0][m][1] * scr_, ya = acc[ai][1][m][0] * scr_, yb = acc[ai][1][m][1] * scr_;
                    u32x4 o1, o2;
                    o1.x = cvt_pk_bf16(xa[0] * t0[0] - ya[0] * t0[1], xa[1] * t0[2] - ya[1] * t0[3]);
                    o1.y = cvt_pk_bf16(xa[2] * t1[0] - ya[2] * t1[1], xa[3] * t1[2] - ya[3] * t1[3]);
                    o1.z = cvt_pk_bf16(xb[0] * t2[0] - yb[0] * t2[1], xb[1] * t2[2] - yb[1] * t2[3]);
                    o1.w = cvt_pk_bf16(xb[2] * t3[0] - yb[2] * t3[1], xb[3] * t3[2] - yb[3] * t3[3]);
                    o2.x = cvt_pk_bf16(xa[0] * t0[1] + ya[0] * t0[0], xa[1] * t0[3] + ya[1] * t0[2]);
                    o2.y = cvt_pk_bf16(xa[2] * t1[1] + ya[2] * t1[0], xa[3] * t1[3] + ya[3] * t1[2]);
                    o2.z = cvt_pk_bf16(xb[0] * t2[1] + yb[0] * t2[0], xb[1] * t2[3] + yb[1] * t2[2]);
                    o2.w = cvt_pk_bf16(xb[2] * t3[1] + yb[2] * t3[0], xb[3] * t3[3] + yb[3] * t3[2]);
                    bf16_t* p = dstb + (size_t)row * 512 + head * 128 + i0;
                    *(u32x4*)p = o1; *(u32x4*)(p + 64) = o2;
                    if (m & 1) asm volatile("" ::: "memory");
                }
        } else {
            const int b = pn >> 1;
            bf16_t* dstb = base + (size_t)b * ((size_t)HT * 512);
            const int col0 = (pn & 1) * 256 + wc * 32 + 8 * fq;
#pragma unroll
            for (int ai = 0; ai < 2; ++ai)
#pragma unroll
                for (int m = 0; m < 4; ++m) {
                    bf16_t* p = dstb + (size_t)(row0 + ai * 128 + m * 16) * 512 + col0;
                    const float r = rs[row0 + ai * 128 + m * 16];
#pragma unroll
                    for (int bj = 0; bj < 2; ++bj) {
                        f32x4 v0 = acc[ai][bj][m][0] * r, v1 = acc[ai][bj][m][1] * r;
                        if (b == 3) {
#pragma unroll
                            for (int j = 0; j < 4; ++j) { v0[j] = silu_f(v0[j]); v1[j] = silu_f(v1[j]); }
                        }
                        u32x4 w; w.x = cvt_pk_bf16(v0[0], v0[1]); w.y = cvt_pk_bf16(v0[2], v0[3]); w.z = cvt_pk_bf16(v1[0], v1[1]); w.w = cvt_pk_bf16(v1[2], v1[3]);
                        *(u32x4*)(p + bj * 128) = w;
                    }
                }
        }
    }
};
struct EpiBf {
    static constexpr bool PERM = true, AFTER_DRAIN = false;
    bf16_t* O;
    __device__ __forceinline__ void operator()(const f32x4 (&acc)[2][2][4][2], const pg8::Unit& u, int wr, int wc, int fr, int fq) const {
        const int row0 = u.pm * 256 + wr * 64 + fr, col0 = u.pn * 256 + wc * 32 + 8 * fq;
#pragma unroll
        for (int ai = 0; ai < 2; ++ai)
#pragma unroll
            for (int m = 0; m < 4; ++m) {
                bf16_t* p = O + (size_t)(row0 + ai * 128 + m * 16) * 1024 + col0;
#pragma unroll
                for (int bj = 0; bj < 2; ++bj) {
                    const f32x4 v0 = acc[ai][bj][m][0], v1 = acc[ai][bj][m][1];
                    u32x4 w; w.x = cvt_pk_bf16(v0[0], v0[1]); w.y = cvt_pk_bf16(v0[2], v0[3]); w.z = cvt_pk_bf16(v1[0], v1[1]); w.w = cvt_pk_bf16(v1[2], v1[3]);
                    *(u32x4*)(p + bj * 128) = w;
                }
            }
    }
};
struct EpiGates {
    static constexpr bool PERM = true, AFTER_DRAIN = false;
    const bf16_t* RET; const bf16_t* FOU; bf16_t* MRG; const float* rs;
    __device__ __forceinline__ void operator()(const f32x4 (&acc)[2][2][4][2], const pg8::Unit& u, int wr, int wc, int fr, int fq) const {
        const int row0 = u.pm * 256 + wr * 64 + fr, col0 = u.pn * 128 + wc * 32 + 8 * fq;
#pragma unroll
        for (int ai = 0; ai < 2; ++ai) {
            u32x4 rv[4], fv[4];
#pragma unroll
            for (int m = 0; m < 4; ++m) { const size_t off = (size_t)(row0 + ai * 128 + m * 16) * 1024 + col0; rv[m] = *(const u32x4*)(RET + off); fv[m] = *(const u32x4*)(FOU + off); }
#pragma unroll
            for (int m = 0; m < 4; ++m) {
                const size_t off = (size_t)(row0 + ai * 128 + m * 16) * 1024 + col0;
                const float r = rs[row0 + ai * 128 + m * 16];
                const f32x4 g0 = acc[ai][0][m][0] * r, g1 = acc[ai][0][m][1] * r, h0 = acc[ai][1][m][0] * r, h1 = acc[ai][1][m][1] * r;
                u32x4 w;
                w.x = cvt_pk_bf16(sigm_f(g0[0]) * bflo(rv[m].x) + sigm_f(h0[0]) * bflo(fv[m].x), sigm_f(g0[1]) * bfhi(rv[m].x) + sigm_f(h0[1]) * bfhi(fv[m].x));
                w.y = cvt_pk_bf16(sigm_f(g0[2]) * bflo(rv[m].y) + sigm_f(h0[2]) * bflo(fv[m].y), sigm_f(g0[3]) * bfhi(rv[m].y) + sigm_f(h0[3]) * bfhi(fv[m].y));
                w.z = cvt_pk_bf16(sigm_f(g1[0]) * bflo(rv[m].z) + sigm_f(h1[0]) * bflo(fv[m].z), sigm_f(g1[1]) * bfhi(rv[m].z) + sigm_f(h1[1]) * bfhi(fv[m].z));
                w.w = cvt_pk_bf16(sigm_f(g1[2]) * bflo(rv[m].w) + sigm_f(h1[2]) * bflo(fv[m].w), sigm_f(g1[3]) * bfhi(rv[m].w) + sigm_f(h1[3]) * bfhi(fv[m].w));
                *(u32x4*)(MRG + off) = w;
            }
            asm volatile("" ::: "memory");
        }
    }
};
template <class Epi, bool ALIGN = GEMM_ALIGN>
__device__ __forceinline__ void run_gemm(LAS unsigned char* lds, const bf16_t* A, const bf16_t* Bt, int M, int N, int K, const Epi& E) {
    pg8::Gemm g; g.A = A; g.Bt = Bt; g.M = M; g.N = N; g.K = K;
    pg8::StaticOrder S; S.init(M, N, (int)gridDim.x, (int)blockIdx.x);
    pg8::gemm_phase<Epi, pg8::StaticOrder, ALIGN, GEMM_SP2>(lds, g, S, E);
    __syncthreads();
}

__device__ __forceinline__ int src_col(int kind, int n) {
    if (kind == 0) return n;
    const int t = n >> 8, r = n & 255;
    if (kind == 1) return (r < 128) ? (t * 128 + r) : (2816 + t * 128 + (r - 128));
    if (t < 4) { const int hi = r >> 7, rr = r & 127, hl = rr >> 6, i = rr & 63, head = 2 * (t & 1) + hl; return (t >> 1) * 512 + head * 128 + 2 * i + hi; }
    if (t < 10) return n;
    const int tg = t - 10; return (r < 128) ? (2560 + tg * 128 + r) : (3584 + tg * 128 + (r - 128));
}
__device__ __forceinline__ void transpose_item(const float* W, int K, int N, bf16_t* WT, int kind, LAS float* scr, int item, int lane, const float* g = nullptr) {
    const int nblk = N / 32, kb = item / nblk, nb = item % nblk, k0 = 64 * kb, n0 = 32 * nb;
    const int sc = src_col(kind, n0 + (lane & 31));
#pragma unroll 8
    for (int i = 0; i < 32; ++i) { const int kk = 2 * i + (lane >> 5); float w = W[(size_t)(k0 + kk) * N + sc]; if (g) w *= g[k0 + kk]; scr[kk * 33 + (lane & 31)] = w; }
    LDS_WAIT();
    const int c = lane & 7;
#pragma unroll
    for (int j = 0; j < 4; ++j) {
        const int n = (lane >> 3) + 8 * j; const LAS float* s = scr + (8 * c) * 33 + n;
        u32x4 o; o.x = cvt_pk_bf16(s[0 * 33], s[1 * 33]); o.y = cvt_pk_bf16(s[2 * 33], s[3 * 33]); o.z = cvt_pk_bf16(s[4 * 33], s[5 * 33]); o.w = cvt_pk_bf16(s[6 * 33], s[7 * 33]);
        *(u32x4*)(WT + (size_t)(n0 + n) * K + k0 + 8 * c) = o;
    }
    LDS_WAIT();
}
__device__ __forceinline__ void phase_prep(const PRef& p, LAS unsigned char* lds, int l, int grp) {
    int tid_ = threadIdx.x; asm volatile("" : "+v"(tid_)); const int tid = tid_, wave = tid >> 6, lane = tid & 63;
    LAS float* scr = (LAS float*)(lds + wave * 8448);
    bf16_t* W = (bf16_t*)(p.ws() + WS_W);
    const int gw = blockIdx.x * 8 + wave, ngw = gridDim.x * 8;
    constexpr int I_FI = 16 * 176, I_FO = 44 * 32, I_WIN = 16 * 144, I_RO = 8 * 32, I_MX = 16 * 32, I_LAYER = 2 * I_FI + 2 * I_FO + I_WIN + 2 * I_RO + I_MX;
    constexpr int I_A = I_FI + I_FO + I_WIN + 2 * I_RO + I_MX;
    const int it0 = (grp & 1) ? 0 : I_A, it1 = (grp & 2) ? I_LAYER : I_A;
    for (int it = it0 + gw; it < it1; it += ngw) {
        int r = it;
        bf16_t* Wl = W;
        if (r < I_FI) { transpose_item(p.in(3) + (size_t)l * 1024 * 5632, 1024, 5632, Wl + WO_F1I, 1, scr, r, lane, p.in(2) + l * 1024); continue; } r -= I_FI;
        if (r < I_FO) { transpose_item(p.in(4) + (size_t)l * 2816 * 1024, 2816, 1024, Wl + WO_F1O, 0, scr, r, lane); continue; } r -= I_FO;
        if (r < I_WIN) { transpose_item(p.in(6) + (size_t)l * 1024 * 4608, 1024, 4608, Wl + WO_WIN, 2, scr, r, lane, p.in(5) + l * 1024); continue; } r -= I_WIN;
        if (r < I_RO) { transpose_item(p.in(9) + (size_t)l * 512 * 1024, 512, 1024, Wl + WO_RET, 0, scr, r, lane); continue; } r -= I_RO;
        if (r < I_RO) { transpose_item(p.in(10) + (size_t)l * 512 * 1024, 512, 1024, Wl + WO_FFT, 0, scr, r, lane); continue; } r -= I_RO;
        if (r < I_MX) { transpose_item(p.in(11) + (size_t)l * 1024 * 1024, 1024, 1024, Wl + WO_MIX, 0, scr, r, lane); continue; } r -= I_MX;
        if (r < I_FI) { transpose_item(p.in(13) + (size_t)l * 1024 * 5632, 1024, 5632, Wl + WO_F2I, 1, scr, r, lane, p.in(12) + l * 1024); continue; } r -= I_FI;
        transpose_item(p.in(14) + (size_t)l * 2816 * 1024, 2816, 1024, Wl + WO_F2O, 0, scr, r, lane);
    }
    if (!(grp & 4)) return;
    f32x2v* rope = (f32x2v*)(p.ws() + WS_ROPE);
    for (int idx = blockIdx.x * 512 + tid; idx < 16384 * 64; idx += gridDim.x * 512) {
        const int pos = idx >> 6, i = idx & 63;
        double f = 1.0;
        for (int q = 0; q < i; ++q) f *= 0.8639884494839686;
        const float inv = (float)f, ang = (float)pos * inv;
        double rev = (double)ang * 0.15915494309189535; rev -= __builtin_floor(rev);
        const float fr = (float)rev;
        f32x2v o; o.x = __builtin_amdgcn_cosf(fr); o.y = __builtin_amdgcn_sinf(fr);
        rope[idx] = o;
    }
}

__device__ __forceinline__ void rows_init(const float* src, bf16_t* xb, float* rs, int nrows) {
    int tid_ = threadIdx.x; asm volatile("" : "+v"(tid_)); const int tid = tid_, wave = tid >> 6, lane = tid & 63;
#pragma unroll 2
    for (int row = blockIdx.x * 8 + wave; row < nrows; row += gridDim.x * 8) {
        const f32x4* xr = (const f32x4*)(src + (size_t)row * 1024) + lane;
        const f32x4 v0 = xr[0], v1 = xr[64], v2 = xr[128], v3 = xr[192];
        float s = (v0[0] * v0[0] + v0[1] * v0[1]) + (v0[2] * v0[2] + v0[3] * v0[3]);
        s += (v1[0] * v1[0] + v1[1] * v1[1]) + (v1[2] * v1[2] + v1[3] * v1[3]);
        s += (v2[0] * v2[0] + v2[1] * v2[1]) + (v2[2] * v2[2] + v2[3] * v2[3]);
        s += (v3[0] * v3[0] + v3[1] * v3[1]) + (v3[2] * v3[2] + v3[3] * v3[3]);
        const float rstd = 1.0f / sqrtf(wave_sum(s) * (1.0f / 1024.0f) + 1e-6f);
        if (lane == 0) rs[row] = rstd;
        u32x2* o = (u32x2*)(xb + (size_t)row * 1024) + lane;
        u32x2 w; w.x = cvt_pk_bf16(v0[0], v0[1]); w.y = cvt_pk_bf16(v0[2], v0[3]); o[0] = w;
        w.x = cvt_pk_bf16(v1[0], v1[1]); w.y = cvt_pk_bf16(v1[2], v1[3]); o[64] = w;
        w.x = cvt_pk_bf16(v2[0], v2[1]); w.y = cvt_pk_bf16(v2[2], v2[3]); o[128] = w;
        w.x = cvt_pk_bf16(v3[0], v3[1]); w.y = cvt_pk_bf16(v3[2], v3[3]); o[192] = w;
    }
}
__device__ __forceinline__ float sumsq8(const u32x4 v) {
    return (bflo(v.x) * bflo(v.x) + bfhi(v.x) * bfhi(v.x)) + (bflo(v.y) * bflo(v.y) + bfhi(v.y) * bfhi(v.y)) + (bflo(v.z) * bflo(v.z) + bfhi(v.z) * bfhi(v.z)) + (bflo(v.w) * bflo(v.w) + bfhi(v.w) * bfhi(v.w));
}
__device__ __forceinline__ void rowstat(const bf16_t* xb, float* rs, int nrows) {
    int tid_ = threadIdx.x; asm volatile("" : "+v"(tid_)); const int tid = tid_, wave = tid >> 6, lane = tid & 63;
    for (int row0 = (blockIdx.x * 8 + wave) * 2; row0 < nrows; row0 += gridDim.x * 16) {
        const u32x4* r0 = (const u32x4*)(xb + (size_t)row0 * 1024) + lane;
        const u32x4 a0 = r0[0], a1 = r0[64], b0 = r0[128], b1 = r0[192];
        const float s0 = wave_sum(sumsq8(a0) + sumsq8(a1)), s1 = wave_sum(sumsq8(b0) + sumsq8(b1));
        if (lane == 0) { rs[row0] = 1.0f / sqrtf(s0 * (1.0f / 1024.0f) + 1e-6f); rs[row0 + 1] = 1.0f / sqrtf(s1 * (1.0f / 1024.0f) + 1e-6f); }
    }
}
__device__ __forceinline__ void rowstat_slots(const float* ss, float* rs, int nrows) {
    int tid_ = threadIdx.x; asm volatile("" : "+v"(tid_));
    for (int row = blockIdx.x * 512 + tid_; row < nrows; row += gridDim.x * 512) {
        const f32x4* p4 = (const f32x4*)(ss + (size_t)row * 16);
        const f32x4 a = p4[0], b = p4[1], c = p4[2], d = p4[3];
        const float s = ((a[0] + a[1]) + (a[2] + a[3])) + ((b[0] + b[1]) + (b[2] + b[3])) + ((c[0] + c[1]) + (c[2] + c[3])) + ((d[0] + d[1]) + (d[2] + d[3]));
        rs[row] = 1.0f / sqrtf(s * (1.0f / 1024.0f) + 1e-6f);
    }
}
__device__ __forceinline__ void final_norm(const bf16_t* xb, const float* g, float* out, int nrows) {
    int tid_ = threadIdx.x; asm volatile("" : "+v"(tid_)); const int tid = tid_, wave = tid >> 6, lane = tid & 63;
    const f32x4* gp = (const f32x4*)g + 2 * lane;
    const f32x4 g0 = gp[0], g1 = gp[1], g2 = gp[128], g3 = gp[129];
    for (int row = (blockIdx.x * 8 + wave) * 2; row < nrows; row += gridDim.x * 16) {
        const u32x4* r0 = (const u32x4*)(xb + (size_t)row * 1024) + lane;
        const u32x4 a = r0[0], b = r0[64], c = r0[128], d = r0[192];
        const float rs0 = 1.0f / sqrtf(wave_sum(sumsq8(a) + sumsq8(b)) * (1.0f / 1024.0f) + 1e-6f);
        const float rs1 = 1.0f / sqrtf(wave_sum(sumsq8(c) + sumsq8(d)) * (1.0f / 1024.0f) + 1e-6f);
        f32x4* o = (f32x4*)(out + (size_t)row * 1024) + 2 * lane;
        *(o + 0) = (f32x4){bflo(a.x), bfhi(a.x), bflo(a.y), bfhi(a.y)} * rs0 * g0;   *(o + 1) = (f32x4){bflo(a.z), bfhi(a.z), bflo(a.w), bfhi(a.w)} * rs0 * g1;
        *(o + 128) = (f32x4){bflo(b.x), bfhi(b.x), bflo(b.y), bfhi(b.y)} * rs0 * g2; *(o + 129) = (f32x4){bflo(b.z), bfhi(b.z), bflo(b.w), bfhi(b.w)} * rs0 * g3;
        *(o + 256) = (f32x4){bflo(c.x), bfhi(c.x), bflo(c.y), bfhi(c.y)} * rs1 * g0; *(o + 257) = (f32x4){bflo(c.z), bfhi(c.z), bflo(c.w), bfhi(c.w)} * rs1 * g1;
        *(o + 384) = (f32x4){bflo(d.x), bfhi(d.x), bflo(d.y), bfhi(d.y)} * rs1 * g2; *(o + 385) = (f32x4){bflo(d.z), bfhi(d.z), bflo(d.w), bfhi(d.w)} * rs1 * g3;
    }
}

__device__ __forceinline__ void mm_tile(f32x4 (&acc)[2][4], const LAS unsigned char* A, const LAS unsigned char* B, int wr, int wc, int fr, int fq, int ksteps) {
    const LAS unsigned char* ap = A + (32 * wr + fr) * TP + fq * 16;
    const LAS unsigned char* bp = B + (64 * wc + fr) * TP + fq * 16;
    bf16x8 a[2], b[4];
#pragma unroll
    for (int mi = 0; mi < 2; ++mi) a[mi] = *(const LAS bf16x8*)(ap + mi * 16 * TP);
#pragma unroll
    for (int ni = 0; ni < 4; ++ni) b[ni] = *(const LAS bf16x8*)(bp + ni * 16 * TP);
#pragma unroll 1
    for (int ks = 0; ks < ksteps; ++ks) {
        bf16x8 an[2], bn[4];
        const int kn = (ks + 1 < ksteps) ? (ks + 1) : ks;
#pragma unroll
        for (int mi = 0; mi < 2; ++mi) an[mi] = *(const LAS bf16x8*)(ap + mi * 16 * TP + kn * 64);
#pragma unroll
        for (int ni = 0; ni < 4; ++ni) bn[ni] = *(const LAS bf16x8*)(bp + ni * 16 * TP + kn * 64);
#pragma unroll
        for (int mi = 0; mi < 2; ++mi)
#pragma unroll
            for (int ni = 0; ni < 4; ++ni) acc[mi][ni] = __builtin_amdgcn_mfma_f32_16x16x32_bf16(b[ni], a[mi], acc[mi][ni], 0, 0, 0);
#pragma unroll
        for (int mi = 0; mi < 2; ++mi) a[mi] = an[mi];
#pragma unroll
        for (int ni = 0; ni < 4; ++ni) b[ni] = bn[ni];
    }
}
__device__ __forceinline__ void zero_acc(f32x4 (&acc)[2][4]) {
#pragma unroll
    for (int mi = 0; mi < 2; ++mi)
#pragma unroll
        for (int ni = 0; ni < 4; ++ni) acc[mi][ni] = (f32x4){0.f, 0.f, 0.f, 0.f};
}
__device__ __forceinline__ void load_nat(LAS unsigned char* dst, const bf16_t* src, size_t ld, int nrows, int tid) {
    for (int id = tid; id < nrows * 16; id += 512) { const int row = id >> 4, c = id & 15; const u32x4 v = *(const u32x4*)(src + (size_t)row * ld + c * 8); *(LAS u32x4*)(dst + row * TP + c * 16) = v; }
}
__device__ __forceinline__ void tr_issue(u32x4 (&r)[4], const bf16_t* src, size_t ld, int nrows, int tid);
__device__ __forceinline__ void tr_commit(LAS unsigned char* dst, const u32x4 (&r)[4], int nrows, int tid);
__device__ __forceinline__ void load_tr(LAS unsigned char* dst, const bf16_t* src, size_t ld, int nrows, int tid) {
    u32x4 r[4]; tr_issue(r, src, ld, nrows, tid); tr_commit(dst, r, nrows, tid);
}
__device__ __forceinline__ void tr_issue(u32x4 (&r)[4], const bf16_t* src, size_t ld, int nrows, int tid) {
    const int ng = nrows >> 2, g = tid & (ng - 1), c = (nrows == 128) ? (tid >> 5) : (tid >> 4);
    if (c < 16) {
#pragma unroll
        for (int q = 0; q < 4; ++q) r[q] = *(const u32x4*)(src + (size_t)(4 * g + q) * ld + c * 8);
    }
}
__device__ __forceinline__ void tr_commit(LAS unsigned char* dst, const u32x4 (&r)[4], int nrows, int tid) {
    const int ng = nrows >> 2, g = tid & (ng - 1), c = (nrows == 128) ? (tid >> 5) : (tid >> 4);
    if (c < 16) {
        LAS unsigned char* d = dst + (8 * c) * TP + g * 8;
#pragma unroll
        for (int w = 0; w < 4; ++w) {
            const unsigned a0 = r[0][w], a1 = r[1][w], a2 = r[2][w], a3 = r[3][w];
            u32x2 lo, hi;
            lo.x = (a0 & 0xffffu) | (a1 << 16); lo.y = (a2 & 0xffffu) | (a3 << 16);
            hi.x = (a0 >> 16) | (a1 & 0xffff0000u); hi.y = (a2 >> 16) | (a3 & 0xffff0000u);
            *(LAS u32x2*)(d + (2 * w) * TP) = lo; *(LAS u32x2*)(d + (2 * w + 1) * TP) = hi;
        }
    }
}
__device__ __forceinline__ void nat_issue(u32x4 (&r)[4], const bf16_t* src, size_t ld, int tid) {
#pragma unroll
    for (int q = 0; q < 4; ++q) { const int id = tid + 512 * q, row = id >> 4, c = id & 15; r[q] = *(const u32x4*)(src + (size_t)row * ld + c * 8); }
}
__device__ __forceinline__ void nat_commit(LAS unsigned char* dst, const u32x4 (&r)[4], int tid) {
#pragma unroll
    for (int q = 0; q < 4; ++q) { const int id = tid + 512 * q, row = id >> 4, c = id & 15; *(LAS u32x4*)(dst + row * TP + c * 16) = r[q]; }
}
__device__ __forceinline__ void store_acc_bf16(bf16_t* dst, size_t ld, const f32x4 (&acc)[2][4], int wr, int wc, int fr, int fq) {
#pragma unroll
    for (int mi = 0; mi < 2; ++mi)
#pragma unroll
        for (int ni = 0; ni < 4; ++ni) {
            u32x2 w; w.x = cvt_pk_bf16(acc[mi][ni][0], acc[mi][ni][1]); w.y = cvt_pk_bf16(acc[mi][ni][2], acc[mi][ni][3]);
            *(u32x2*)(dst + (size_t)(32 * wr + 16 * mi + fr) * ld + 64 * wc + 16 * ni + 4 * fq) = w;
        }
}
__device__ __forceinline__ void store_acc_lds(LAS unsigned char* dst, const f32x4 (&acc)[2][4], int wr, int wc, int fr, int fq) {
#pragma unroll
    for (int mi = 0; mi < 2; ++mi)
#pragma unroll
        for (int ni = 0; ni < 4; ++ni) {
            u32x2 w; w.x = cvt_pk_bf16(acc[mi][ni][0], acc[mi][ni][1]); w.y = cvt_pk_bf16(acc[mi][ni][2], acc[mi][ni][3]);
            *(LAS u32x2*)(dst + (32 * wr + 16 * mi + fr) * TP + (64 * wc + 16 * ni + 4 * fq) * 2) = w;
        }
}

__device__ __forceinline__ void phase_RA(const PRef& p, LAS unsigned char* lds, int l, int h) {
    int tid_ = threadIdx.x; asm volatile("" : "+v"(tid_)); const int tid = tid_, wid = tid >> 6, lane = tid & 63, wr = wid >> 1, wc = wid & 1, fr = lane & 15, fq = lane >> 4;
    unsigned char* hb = p.ws() + WS_HB + (size_t)h * HB_STRIDE; unsigned char* db = (unsigned char*)p.out() + (size_t)h * DO_STRIDE;
    const bf16_t* Kb = (const bf16_t*)(hb + HB_K);
    const bf16_t* Vb = (const bf16_t*)(hb + HB_V);
    bf16_t* KVF = (bf16_t*)(db + DO_KVF); bf16_t* KVB = (bf16_t*)(db + DO_KVB);
    LAS unsigned char* R0 = lds; LAS unsigned char* R1 = lds + TREG; LAS unsigned char* R2 = lds + 2 * TREG;
    u32x4 kvr[4], vvr[4];
    const int g4 = tid & 31, cc = tid >> 5;
    if (blockIdx.x < 1024) {
        const int u = blockIdx.x, c = u >> 2, hd = u & 3;
        tr_issue(kvr, Kb + (size_t)(c * 128) * 512 + hd * 128, 512, 128, tid); tr_issue(vvr, Vb + (size_t)(c * 128) * 512 + hd * 128, 512, 128, tid);
    }
    for (int u = blockIdx.x; u < 1024; u += gridDim.x) {
        const int hd = u & 3;
        const float lf2 = p.in(7)[l * 4 + hd] * LOG2E, lb2 = p.in(8)[l * 4 + hd] * LOG2E;
        tr_commit(R0, vvr, 128, tid);
        {
            float df[4], dbk[4];
#pragma unroll
            for (int q = 0; q < 4; ++q) { const int j = 4 * g4 + q; df[q] = __builtin_amdgcn_exp2f(lf2 * (float)(127 - j)); dbk[q] = __builtin_amdgcn_exp2f(lb2 * (float)(j + 1)); }
            const int o = (8 * cc) * TP + g4 * 8;
#pragma unroll
            for (int w = 0; w < 4; ++w) {
                const unsigned a0 = kvr[0][w], a1 = kvr[1][w], a2 = kvr[2][w], a3 = kvr[3][w];
                u32x2 t;
                t.x = cvt_pk_bf16(bflo(a0) * df[0], bflo(a1) * df[1]); t.y = cvt_pk_bf16(bflo(a2) * df[2], bflo(a3) * df[3]); *(LAS u32x2*)(R1 + o + (2 * w) * TP) = t;
                t.x = cvt_pk_bf16(bfhi(a0) * df[0], bfhi(a1) * df[1]); t.y = cvt_pk_bf16(bfhi(a2) * df[2], bfhi(a3) * df[3]); *(LAS u32x2*)(R1 + o + (2 * w + 1) * TP) = t;
                t.x = cvt_pk_bf16(bflo(a0) * dbk[0], bflo(a1) * dbk[1]); t.y = cvt_pk_bf16(bflo(a2) * dbk[2], bflo(a3) * dbk[3]); *(LAS u32x2*)(R2 + o + (2 * w) * TP) = t;
                t.x = cvt_pk_bf16(bfhi(a0) * dbk[0], bfhi(a1) * dbk[1]); t.y = cvt_pk_bf16(bfhi(a2) * dbk[2], bfhi(a3) * dbk[3]); *(LAS u32x2*)(R2 + o + (2 * w + 1) * TP) = t;
            }
        }
        __syncthreads();
        { const int un = u + gridDim.x; if (un < 1024) {
            const int c = un >> 2, hdn = un & 3;
            tr_issue(kvr, Kb + (size_t)(c * 128) * 512 + hdn * 128, 512, 128, tid); tr_issue(vvr, Vb + (size_t)(c * 128) * 512 + hdn * 128, 512, 128, tid);
        } }
        f32x4 acc[2][4];
        zero_acc(acc); mm_tile(acc, R0, R1, wr, wc, fr, fq, 4); store_acc_bf16(KVF + (size_t)u * 16384, 128, acc, wr, wc, fr, fq);
        zero_acc(acc); mm_tile(acc, R0, R2, wr, wc, fr, fq, 4); store_acc_bf16(KVB + (size_t)u * 16384, 128, acc, wr, wc, fr, fq);
        __syncthreads();
    }
}
__device__ __forceinline__ void phase_RB(const PRef& p, int l, int h) {
    const int nseq = h ? 4 : 2, ncs = h ? 64 : 128;
    const int ntasks = nseq * 65536;
    int tid_ = threadIdx.x; asm volatile("" : "+v"(tid_));
    for (int task = blockIdx.x * 512 + tid_; task < ntasks; task += gridDim.x * 512) {
        const int pp = task & 8191, dir = (task >> 13) & 1, hd = (task >> 14) & 3, seq = task >> 16;
        unsigned* base = (unsigned*)((unsigned char*)p.out() + (size_t)h * DO_STRIDE + (dir ? DO_KVB : DO_KVF)) + ((size_t)(seq * ncs) * 4 + hd) * 8192 + pp;
        const float ld = dir ? p.in(8)[l * 4 + hd] : p.in(7)[l * 4 + hd];
        const float dec = __builtin_amdgcn_exp2f(ld * LOG2E * 128.0f);
        float s0 = 0.f, s1 = 0.f;
        for (int c0 = 0; c0 < ncs; c0 += 32) {
            unsigned v[32];
#pragma unroll
            for (int i = 0; i < 32; ++i) { const int cc = dir ? (ncs - 1 - (c0 + i)) : (c0 + i); v[i] = base[(size_t)cc * 32768]; }
#pragma unroll
            for (int i = 0; i < 32; ++i) { const int cc = dir ? (ncs - 1 - (c0 + i)) : (c0 + i); base[(size_t)cc * 32768] = cvt_pk_bf16(s0, s1); s0 = s0 * dec + bflo(v[i]); s1 = s1 * dec + bfhi(v[i]); }
        }
    }
}
__device__ __forceinline__ void phase_RC(const PRef& p, LAS unsigned char* lds, int l, int h) {
    int tid_ = threadIdx.x; asm volatile("" : "+v"(tid_)); const int tid = tid_, wid = tid >> 6, lane = tid & 63, wr = wid >> 1, wc = wid & 1, fr = lane & 15, fq = lane >> 4;
    unsigned char* hb = p.ws() + WS_HB + (size_t)h * HB_STRIDE; unsigned char* db = (unsigned char*)p.out() + (size_t)h * DO_STRIDE;
    const bf16_t* Qb = (const bf16_t*)(hb + HB_Q);
    const bf16_t* Kb = (const bf16_t*)(hb + HB_K); const bf16_t* Vb = (const bf16_t*)(hb + HB_V); const bf16_t* SGb = (const bf16_t*)(hb + HB_SG);
    const bf16_t* KVF = (const bf16_t*)(db + DO_KVF); const bf16_t* KVB = (const bf16_t*)(db + DO_KVB);
    bf16_t* Rb = (bf16_t*)(hb + HB_Q);
    LAS unsigned char* R0 = lds; LAS unsigned char* R1 = lds + TREG; LAS unsigned char* R2 = lds + 2 * TREG; LAS unsigned char* R3 = lds + 3 * TREG;
    for (int u = blockIdx.x; u < 1024; u += gridDim.x) {
        const int c = u >> 2, hd = u & 3;
        const float lf2 = p.in(7)[l * 4 + hd] * LOG2E, lb2 = p.in(8)[l * 4 + hd] * LOG2E;
        const size_t toff = (size_t)(c * 128) * 512 + hd * 128;
        load_nat(R0, Qb + toff, 512, 128, tid); load_nat(R1, Kb + toff, 512, 128, tid); load_tr(R2, Vb + toff, 512, 128, tid); load_nat(R3, KVF + (size_t)u * 16384, 128, 128, tid);
        __syncthreads();
        f32x4 accS[2][4], accY[2][4];
        u32x4 sbr[4]; nat_issue(sbr, KVB + (size_t)u * 16384, 128, tid);
        zero_acc(accS); mm_tile(accS, R0, R1, wr, wc, fr, fq, 4);
        zero_acc(accY); mm_tile(accY, R0, R3, wr, wc, fr, fq, 4);
        __syncthreads();
#pragma unroll
        for (int mi = 0; mi < 2; ++mi) {
            const int i = 32 * wr + 16 * mi + fr;
            const float af = __builtin_amdgcn_exp2f(lf2 * (float)(i + 1));
#pragma unroll
            for (int ni = 0; ni < 4; ++ni) {
                const int j0 = 64 * wc + 16 * ni + 4 * fq;
                float pv[4];
#pragma unroll
                for (int jj = 0; jj < 4; ++jj) { const int d = i - (j0 + jj); const float w = (d >= 0) ? __builtin_amdgcn_exp2f(lf2 * (float)d) : __builtin_amdgcn_exp2f(lb2 * (float)(-d)); pv[jj] = accS[mi][ni][jj] * w; }
                u32x2 w2; w2.x = cvt_pk_bf16(pv[0], pv[1]); w2.y = cvt_pk_bf16(pv[2], pv[3]);
                *(LAS u32x2*)(R1 + i * TP + j0 * 2) = w2;
                accY[mi][ni] = accY[mi][ni] * af;
            }
        }
        nat_commit(R3, sbr, tid);
        __syncthreads();
        mm_tile(accY, R1, R2, wr, wc, fr, fq, 4);
        f32x4 acc3[2][4];
        zero_acc(acc3); mm_tile(acc3, R0, R3, wr, wc, fr, fq, 4);
        LAS f32x2v* st = (LAS f32x2v*)(lds + LDS_ST);
#pragma unroll
        for (int mi = 0; mi < 2; ++mi) {
            const int i = 32 * wr + 16 * mi + fr;
            const float ab = __builtin_amdgcn_exp2f(lb2 * (float)(127 - i));
            float s = 0.f, q = 0.f;
#pragma unroll
            for (int ni = 0; ni < 4; ++ni) {
                const f32x4 y = accY[mi][ni] + ab * acc3[mi][ni];
                accY[mi][ni] = y;
                s += (y[0] + y[1]) + (y[2] + y[3]); q += (y[0] * y[0] + y[1] * y[1]) + (y[2] * y[2] + y[3] * y[3]);
            }
            s += __shfl_xor(s, 16); s += __shfl_xor(s, 32); q += __shfl_xor(q, 16); q += __shfl_xor(q, 32);
            if (fq == 0) st[i * 2 + wc] = (f32x2v){s, q};
        }
        __syncthreads();
#pragma unroll
        for (int mi = 0; mi < 2; ++mi) {
            const int i = 32 * wr + 16 * mi + fr;
            const f32x2v a = st[i * 2 + 0], b = st[i * 2 + 1];
            const float mean = (a.x + b.x) * (1.0f / 128.0f), var = (a.y + b.y) * (1.0f / 128.0f) - mean * mean;
            const float rs = 1.0f / sqrtf(fmaxf(var, 0.f) + 1e-6f);
#pragma unroll
            for (int ni = 0; ni < 4; ++ni) {
                const size_t off = toff + (size_t)i * 512 + 64 * wc + 16 * ni + 4 * fq;
                const u32x2 sg = *(const u32x2*)(SGb + off);
                const f32x4 y = accY[mi][ni];
                u32x2 w2; w2.x = cvt_pk_bf16(bflo(sg.x) * (y[0] - mean) * rs, bfhi(sg.x) * (y[1] - mean) * rs); w2.y = cvt_pk_bf16(bflo(sg.y) * (y[2] - mean) * rs, bfhi(sg.y) * (y[3] - mean) * rs);
                *(u32x2*)(Rb + off) = w2;
            }
        }
        __syncthreads();
    }
}

__device__ __forceinline__ void fill_dft(LAS unsigned char* R0, LAS unsigned char* R1, int N, int tid) {
    const int sh = (N == 128) ? 7 : 6;
    const float invN = 1.0f / (float)N;
    for (int idx = tid; idx < N * N; idx += 512) {
        const int k = idx >> sh, n = idx & (N - 1);
        const float a = (float)((k * n) & (N - 1)) * invN;
        const unsigned pk = cvt_pk_bf16(__builtin_amdgcn_cosf(a), __builtin_amdgcn_sinf(a));
        *(LAS unsigned short*)(R0 + k * TP + n * 2) = (unsigned short)(pk & 0xffffu);
        *(LAS unsigned short*)(R1 + k * TP + n * 2) = (unsigned short)(pk >> 16);
    }
}
__device__ __forceinline__ void phase_FA(const PRef& p, LAS unsigned char* lds, int h) {
    int tid_ = threadIdx.x; asm volatile("" : "+v"(tid_)); const int tid = tid_, wid = tid >> 6, lane = tid & 63, wr = wid >> 1, wc = wid & 1, fr = lane & 15, fq = lane >> 4;
    const int N1 = h ? 64 : 128, nseq = h ? 4 : 2, S = N1 * 128, nunits = nseq * 512, ksteps = N1 / 32;
    const float invS = 1.0f / (float)S;
    const bf16_t* Fb = (const bf16_t*)(p.ws() + WS_HB + (size_t)h * HB_STRIDE + HB_F);
    unsigned char* db = (unsigned char*)p.out() + (size_t)h * DO_STRIDE;
    bf16_t* APR = (bf16_t*)(db + DO_APR); bf16_t* API = (bf16_t*)(db + DO_API);
    LAS unsigned char* R0 = lds; LAS unsigned char* R1 = lds + TREG; LAS unsigned char* R2 = lds + 2 * TREG;
    fill_dft(R0, R1, N1, tid);
    __syncthreads();
    u32x4 pf[4];
    if ((int)blockIdx.x < nunits) { const int u = blockIdx.x, g = u & 3, n2 = (u >> 2) & 127, seq = u >> 9; tr_issue(pf, Fb + ((size_t)seq * S + n2) * 512 + g * 128, (size_t)128 * 512, N1, tid); }
    for (int u = blockIdx.x; u < nunits; u += gridDim.x) {
        const int g = u & 3, n2 = (u >> 2) & 127, seq = u >> 9;
        tr_commit(R2, pf, N1, tid);
        __syncthreads();
        { const int un = u + gridDim.x; if (un < nunits) { const int gn = un & 3, n2n = (un >> 2) & 127, seqn = un >> 9; tr_issue(pf, Fb + ((size_t)seqn * S + n2n) * 512 + gn * 128, (size_t)128 * 512, N1, tid); } }
        if (64 * wr <= N1) {
            f32x4 P1[2][4], P2[2][4];
            zero_acc(P1); mm_tile(P1, R0, R2, wr, wc, fr, fq, ksteps);
            zero_acc(P2); mm_tile(P2, R1, R2, wr, wc, fr, fq, ksteps);
#pragma unroll
            for (int mi = 0; mi < 2; ++mi) {
                const int k1 = 32 * wr + 16 * mi + fr;
                const float a = (float)(n2 * k1) * invS, cs = __builtin_amdgcn_cosf(a), sn = __builtin_amdgcn_sinf(a);
                const size_t rowoff = ((size_t)seq * S + (size_t)k1 * 128 + n2) * 512 + g * 128 + 64 * wc + 4 * fq;
                if (2 * k1 <= N1) {
#pragma unroll
                for (int ni = 0; ni < 4; ++ni) {
                    const f32x4 re = P1[mi][ni] * cs - P2[mi][ni] * sn, im = -(P2[mi][ni] * cs + P1[mi][ni] * sn);
                    u32x2 w; w.x = cvt_pk_bf16(re[0], re[1]); w.y = cvt_pk_bf16(re[2], re[3]); *(u32x2*)(APR + rowoff + 16 * ni) = w;
                    w.x = cvt_pk_bf16(im[0], im[1]); w.y = cvt_pk_bf16(im[2], im[3]); *(u32x2*)(API + rowoff + 16 * ni) = w;
                }
                }
            }
        }
        __syncthreads();
    }
}
__device__ __forceinline__ void phase_FB(const PRef& p, LAS unsigned char* lds, int h) {
    int tid_ = threadIdx.x; asm volatile("" : "+v"(tid_)); const int tid = tid_, wid = tid >> 6, lane = tid & 63, wr = wid >> 1, wc = wid & 1, fr = lane & 15, fq = lane >> 4;
    const int N1 = h ? 64 : 128, nseq = h ? 4 : 2, S = N1 * 128, nk = N1 / 2 - 1, ND = nseq * nk * 4, NSLOT = ND + nseq * 4;
    const float scale = h ? 0.0009765625f : 0.0006905339660024878f;
    unsigned char* db = (unsigned char*)p.out() + (size_t)h * DO_STRIDE;
    const bf16_t* APR = (const bf16_t*)(db + DO_APR); const bf16_t* API = (const bf16_t*)(db + DO_API);
    bf16_t* FR = (bf16_t*)(p.ws() + WS_HB + (size_t)h * HB_STRIDE + HB_F);
    LAS unsigned char* R0 = lds; LAS unsigned char* R1 = lds + TREG; LAS unsigned char* R2 = lds + 2 * TREG; LAS unsigned char* R3 = lds + 3 * TREG;
    fill_dft(R0, R1, 128, tid);
    __syncthreads();
    for (int sl = blockIdx.x; sl < NSLOT; sl += gridDim.x) {
        const int nit = (sl < ND) ? 1 : 2;
#pragma unroll 1
        for (int e = 0; e < nit; ++e) {
            int g, k1, seq; bool mirror;
            if (sl < ND) { g = sl & 3; const int t = sl >> 2; seq = t / nk; k1 = t - seq * nk + 1; mirror = true; }
            else { const int sidx = 2 * (sl - ND) + e; g = sidx & 3; k1 = ((sidx >> 2) & 1) ? N1 / 2 : 0; seq = sidx >> 3; mirror = false; }
            const size_t soff = ((size_t)seq * S + (size_t)k1 * 128) * 512 + g * 128;
            load_tr(R2, APR + soff, 512, 128, tid); load_tr(R3, API + soff, 512, 128, tid);
            __syncthreads();
            f32x4 aR[2][4], a3[2][4], a4[2][4];
            zero_acc(aR); mm_tile(aR, R0, R2, wr, wc, fr, fq, 4); mm_tile(aR, R1, R3, wr, wc, fr, fq, 4);
            zero_acc(a3); mm_tile(a3, R0, R3, wr, wc, fr, fq, 4);
            zero_acc(a4); mm_tile(a4, R1, R2, wr, wc, fr, fq, 4);
            __syncthreads();
#pragma unroll
            for (int mi = 0; mi < 2; ++mi)
#pragma unroll
                for (int ni = 0; ni < 4; ++ni) a3[mi][ni] = a3[mi][ni] - a4[mi][ni];
            store_acc_lds(R2, aR, wr, wc, fr, fq); store_acc_lds(R3, a3, wr, wc, fr, fq);
            __syncthreads();
            zero_acc(aR); mm_tile(aR, R2, R0, wr, wc, fr, fq, 4);
            zero_acc(a3); mm_tile(a3, R3, R1, wr, wc, fr, fq, 4);
#pragma unroll
            for (int mi = 0; mi < 2; ++mi) {
                const int k2 = 32 * wr + 16 * mi + fr;
                const size_t coloff = (size_t)g * 128 + 64 * wc + 4 * fq;
                const size_t row = (size_t)seq * S + k1 + (size_t)N1 * k2, mrow = (size_t)seq * S + (N1 - k1) + (size_t)N1 * (127 - k2);
#pragma unroll
                for (int ni = 0; ni < 4; ++ni) {
                    const f32x4 o = (aR[mi][ni] + a3[mi][ni]) * scale;
                    u32x2 w; w.x = cvt_pk_bf16(o[0], o[1]); w.y = cvt_pk_bf16(o[2], o[3]); *(u32x2*)(FR + row * 512 + coloff + 16 * ni) = w;
                    if (mirror) {
                        const f32x4 om = (aR[mi][ni] - a3[mi][ni]) * scale;
                        u32x2 wm; wm.x = cvt_pk_bf16(om[0], om[1]); wm.y = cvt_pk_bf16(om[2], om[3]); *(u32x2*)(FR + mrow * 512 + coloff + 16 * ni) = wm;
                    }
                }
            }
            __syncthreads();
        }
    }
}

struct Ctx { unsigned char* ws; unsigned char* dout; bf16_t* XB; float* RS; float* SS; const bf16_t* Wl; };
__device__ __forceinline__ void st_ffn_in(const Ctx& c, LAS unsigned char* lds, int hh, int second) {
    EpiSwiGLU E; E.U = hh ? (bf16_t*)(c.dout + DO_U1) : (bf16_t*)(c.ws + WS_U0); E.rs = c.RS + hh * HT;
    run_gemm(lds, c.XB + (size_t)hh * HT * 1024, c.Wl + (second ? WO_F2I : WO_F1I), HT, 5632, 1024, E);
}
__device__ __forceinline__ void st_ffn_out(const Ctx& c, LAS unsigned char* lds, int hh, int second) {
    EpiRes E; E.X = c.XB + (size_t)hh * HT * 1024; E.ss = c.SS + (size_t)hh * HT * 16; E.scale = 0.5f;
    run_gemm(lds, hh ? (const bf16_t*)(c.dout + DO_U1) : (const bf16_t*)(c.ws + WS_U0), c.Wl + (second ? WO_F2O : WO_F1O), HT, 1024, 2816, E);
}
__device__ __forceinline__ void st_rowstat(const Ctx& c, int hh) { rowstat_slots(c.SS + (size_t)hh * HT * 16, c.RS + hh * HT, HT); }
__device__ __forceinline__ void st_win(const Ctx& c, LAS unsigned char* lds, int hh) {
    EpiWin E; E.base = (bf16_t*)(c.ws + WS_HB + (size_t)hh * HB_STRIDE); E.rope = (const float*)(c.ws + WS_ROPE); E.rs = c.RS + hh * HT; E.smask = hh ? 8191 : 16383;
    run_gemm(lds, c.XB + (size_t)hh * HT * 1024, c.Wl + WO_WIN, HT, 2560, 1024, E);
}
__device__ __forceinline__ void st_retfou(const Ctx& c, LAS unsigned char* lds, int hh) {
    unsigned char* hb = c.ws + WS_HB + (size_t)hh * HB_STRIDE; unsigned char* db = c.dout + (size_t)hh * DO_STRIDE;
#pragma unroll 1
    for (int t = 0; t < 2; ++t) {
        EpiBf E; E.O = t ? (bf16_t*)(db + DO_FOU) : (bf16_t*)(hb + HB_RET);
        run_gemm(lds, (const bf16_t*)(hb + (t ? HB_F : HB_Q)), c.Wl + (t ? WO_FFT : WO_RET), HT, 1024, 512, E);
    }
}
__device__ __forceinline__ void st_gates(const Ctx& c, LAS unsigned char* lds, int hh) {
    unsigned char* hb = c.ws + WS_HB + (size_t)hh * HB_STRIDE; unsigned char* db = c.dout + (size_t)hh * DO_STRIDE;
    EpiGates E; E.RET = (const bf16_t*)(hb + HB_RET); E.FOU = (const bf16_t*)(db + DO_FOU); E.MRG = (bf16_t*)(db + DO_MRG); E.rs = c.RS + hh * HT;
    run_gemm(lds, c.XB + (size_t)hh * HT * 1024, c.Wl + WO_WIN + 2560ull * 1024, HT, 2048, 1024, E);
}
__device__ __forceinline__ void st_mix(const Ctx& c, LAS unsigned char* lds, int hh) {
    EpiRes E; E.X = c.XB + (size_t)hh * HT * 1024; E.ss = c.SS + (size_t)hh * HT * 16; E.scale = 1.0f;
    run_gemm(lds, (const bf16_t*)(c.dout + (size_t)hh * DO_STRIDE + DO_MRG), c.Wl + WO_MIX, HT, 1024, 1024, E);
}
__device__ __forceinline__ void run_phase(const PRef& p, LAS unsigned char* lds, int ph) {
    Ctx c; c.ws = p.ws(); c.dout = (unsigned char*)p.out(); c.XB = (bf16_t*)(c.ws + WS_XB); c.RS = (float*)(c.ws + WS_RS); c.SS = (float*)(c.ws + WS_SS); c.Wl = (const bf16_t*)(c.ws + WS_W);
    if (ph == 0) {
        phase_prep(p, lds, 0, 7);
        rows_init(p.in(0), c.XB, c.RS, HT); rows_init(p.in(1), c.XB + (size_t)HT * 1024, c.RS + HT, HT);
        return;
    }
    if (ph == NPHASES - 1) { final_norm(c.XB, p.in(15), p.out(), 2 * HT); return; }
    const int q = ph - 1, l = q / 14, s = q % 14;
    switch (s) {
    case 0:  st_ffn_in(c, lds, 0, 0); if (l > 0) st_rowstat(c, 1); break;
    case 1:  st_ffn_out(c, lds, 0, 0); st_ffn_in(c, lds, 1, 0); break;
    case 2:  st_ffn_out(c, lds, 1, 0); st_rowstat(c, 0); if (l > 0) phase_prep(p, lds, l, 2); break;
    case 3:  st_win(c, lds, 0); st_rowstat(c, 1); break;
    case 4:  st_win(c, lds, 1); phase_RA(p, lds, l, 0); phase_FA(p, lds, 0); break;
    case 5:  phase_RA(p, lds, l, 1); phase_FA(p, lds, 1); phase_RB(p, l, 0); phase_FB(p, lds, 0); break;
    case 6:  phase_RC(p, lds, l, 0); phase_RB(p, l, 1); phase_FB(p, lds, 1); break;
    case 7:  st_retfou(c, lds, 0); phase_RC(p, lds, l, 1); break;
    case 8:  st_gates(c, lds, 0); st_retfou(c, lds, 1); break;
    case 9:  st_mix(c, lds, 0); st_gates(c, lds, 1); break;
    case 10: st_mix(c, lds, 1); st_rowstat(c, 0); break;
    case 11: st_ffn_in(c, lds, 0, 1); st_rowstat(c, 1); if (l == 0) phase_prep(p, lds, l + 1, 1); break;
    case 12: st_ffn_out(c, lds, 0, 1); st_ffn_in(c, lds, 1, 1); break;
    default: st_ffn_out(c, lds, 1, 1); if (l == 0) st_rowstat(c, 0); break;
    }
}

__global__ void __launch_bounds__(512, 2) fwd_megakernel(Params p0) {
    extern __shared__ __attribute__((aligned(16))) unsigned char shm[];
    LAS unsigned char* lds = (LAS unsigned char*)shm;
    volatile LAS unsigned* st = (volatile LAS unsigned*)(lds + LDS_TILES);
    if (threadIdx.x == 0) { st[0] = 0u; st[1] = 0u; }
    __syncthreads();
    (void)xcd_barrier_post((unsigned*)(p0.ws + WS_CTL), st);
    const int ph_lo = p0.ph_lo, ph_hi = p0.ph_hi;
    for (int ph = ph_lo; ph < ph_hi; ++ph) {
        PRef p; p.kp = (const AS4 Params*)__builtin_amdgcn_kernarg_segment_ptr();
        asm volatile("" : "+s"(p.kp));
        run_phase(p, lds, ph);
        if (ph + 1 < ph_hi) {
            if (ph == ph_lo) { __threadfence(); cg::this_grid().sync(); }
            else { XcdBarrier xb; xb.bar = (unsigned*)(p.ws() + WS_CTL); xb.x = xb_xcc_id(); xb.st = (volatile LAS unsigned*)(lds + LDS_TILES); xcd_barrier(xb);
#ifdef DBLBAR
                xcd_barrier(xb);
#endif
            }
        }
    }
}

extern "C" void kernel_launch(void* const* d_in, const int* in_sizes, int n_in, void* d_out, int out_size, void* d_ws, size_t ws_size, hipStream_t stream) {
    static int grid = 0;
    if (grid == 0) {
        if (n_in != 16 || out_size != 2 * HT * 1024 || ws_size < WS_END) { fprintf(stderr, "kernel_launch: unexpected shapes (n_in %d out %d ws %zu)\n", n_in, out_size, ws_size); grid = -1; return; }
        int dev = 0, cus = 0, per_cu = 0;
        if (hipGetDevice(&dev) != hipSuccess || hipDeviceGetAttribute(&cus, hipDeviceAttributeMultiprocessorCount, dev) != hipSuccess) { grid = -1; return; }
        if (hipFuncSetAttribute((const void*)fwd_megakernel, hipFuncAttributeMaxDynamicSharedMemorySize, LDS_BYTES) != hipSuccess) { fprintf(stderr, "kernel_launch: hipFuncSetAttribute failed\n"); grid = -1; return; }
        if (hipOccupancyMaxActiveBlocksPerMultiprocessor(&per_cu, (const void*)fwd_megakernel, 512, LDS_BYTES) != hipSuccess || per_cu < 1) { fprintf(stderr, "kernel_launch: occupancy query says %d\n", per_cu); per_cu = 1; }
        (void)hipGetLastError();
        grid = cus;
    }
    if (grid < 0) return;
    if (hipMemsetAsync((unsigned char*)d_ws + WS_CTL, 0, XCD_BAR_WORDS * sizeof(unsigned), stream) != hipSuccess) return;
    Params p{};
    for (int i = 0; i < 16; ++i) p.in[i] = (const float*)d_in[i];
    p.out = (float*)d_out; p.ws = (unsigned char*)d_ws;
#if MK_ONE_LAUNCH
    p.ph_lo = 0; p.ph_hi = NPHASES;
    void* args[] = {&p};
    hipError_t e = hipLaunchCooperativeKernel((const void*)fwd_megakernel, dim3(grid), dim3(512), args, LDS_BYTES, stream);
    if (e != hipSuccess) fprintf(stderr, "cooperative launch failed: %s (grid %d)\n", hipGetErrorString(e), grid);
#else
    for (int ph = 0; ph < NPHASES; ++ph) {
        p.ph_lo = ph; p.ph_hi = ph + 1;
        hipLaunchKernelGGL(fwd_megakernel, dim3(grid), dim3(512), LDS_BYTES, stream, p);
    }
#endif
}
```
